# Optimizing an MI355X kernel written in HIP

```python
import jax, jax.numpy as jnp
from jax import lax
import numpy as np

D_MODEL = 2048
BATCH = 2
SEQ = 8192
DEPTH = 1

GDN_QK_HEADS = 16
GDN_V_HEADS = 32
GDN_HEAD_DIM = 128
GDN_QK_WIDTH = GDN_QK_HEADS * GDN_HEAD_DIM
GDN_V_WIDTH = GDN_V_HEADS * GDN_HEAD_DIM
MLSTM_HEADS = 8
MLSTM_QK_DIM = D_MODEL // 16
MLSTM_V_DIM = D_MODEL // 8
MLSTM_QK_WIDTH = MLSTM_HEADS * MLSTM_QK_DIM
MLSTM_V_WIDTH = MLSTM_HEADS * MLSTM_V_DIM
CONV_WIDTH = 4
CHUNK = 64
NORM_EPS = 1e-6

IN_SPLITS = (
    2 * GDN_QK_WIDTH + GDN_V_WIDTH,
    GDN_V_HEADS,
    GDN_V_HEADS,
    GDN_V_WIDTH,
    2 * MLSTM_QK_WIDTH,
    MLSTM_V_WIDTH,
    MLSTM_HEADS,
    MLSTM_HEADS,
    MLSTM_V_WIDTH,
    MLSTM_V_WIDTH,
    D_MODEL,
    D_MODEL,
)
IN_WIDTH = sum(IN_SPLITS)

kernel_name = "hybrid_gdn_mlstm_gated_merge"


def rms_norm(x, w):
    xf = x.astype(jnp.float32)
    y = xf * lax.rsqrt(jnp.mean(xf * xf, axis=-1, keepdims=True) + NORM_EPS)
    return (y * w.astype(jnp.float32)).astype(x.dtype)


def l2_normalize(x):
    xf = x.astype(jnp.float32)
    return xf * lax.rsqrt(jnp.sum(xf * xf, axis=-1, keepdims=True) + NORM_EPS)


def causal_conv_silu(x, w):
    k_width, s = w.shape[0], x.shape[1]
    xp = jnp.pad(x, ((0, 0), (k_width - 1, 0), (0, 0)))
    y = sum(xp[:, j:j + s] * w[j] for j in range(k_width))
    return jax.nn.silu(y)


def to_chunks(x):
    b, s, h = x.shape[:3]
    x = x.reshape((b, s // CHUNK, CHUNK, h) + x.shape[3:])
    return jnp.moveaxis(x, (1, 3), (0, 2))


def from_chunks(x):
    x = jnp.moveaxis(x, (0, 2), (1, 3))
    b, nc, c, h, d = x.shape
    return x.reshape(b, nc * c, h, d)


def gated_delta_rule(q, k, v, g, beta):
    f32 = jnp.float32
    qc, kc, vc = (to_chunks(t.astype(f32)) for t in (q, k, v))
    gc, bc = to_chunks(g.astype(f32)), to_chunks(beta.astype(f32))
    dv = vc.shape[-1]
    causal = jnp.tril(jnp.ones((CHUNK, CHUNK), bool))
    strict = jnp.tril(jnp.ones((CHUNK, CHUNK), bool), -1)
    g_cum = jnp.cumsum(gc, axis=-1)
    decay = jnp.exp(jnp.where(causal, g_cum[..., :, None] - g_cum[..., None, :], -jnp.inf))
    k_beta = kc * bc[..., None]
    v_beta = vc * bc[..., None]
    lower = jnp.where(strict, jnp.einsum('nbhid,nbhjd->nbhij', k_beta, kc) * decay, 0.0)
    unit_lower = lower + jnp.eye(CHUNK, dtype=f32)
    rhs = jnp.concatenate([v_beta, k_beta * jnp.exp(g_cum)[..., None]], axis=-1)
    sol = lax.linalg.triangular_solve(unit_lower, rhs, left_side=True, lower=True, unit_diagonal=True)
    u, w = sol[..., :dv], sol[..., dv:]
    attn = jnp.einsum('nbhid,nbhjd->nbhij', qc, kc) * decay
    q_decay = qc * jnp.exp(g_cum)[..., None]
    k_tail = kc * jnp.exp(g_cum[..., -1:] - g_cum)[..., None]
    g_total = jnp.exp(g_cum[..., -1])

    def step(state, inp):
        attn_c, u_c, w_c, qd_c, kt_c, gt_c = inp
        v_new = u_c - jnp.einsum('bhck,bhkv->bhcv', w_c, state)
        o = jnp.einsum('bhck,bhkv->bhcv', qd_c, state) + jnp.einsum('bhij,bhjv->bhiv', attn_c, v_new)
        state = state * gt_c[..., None, None] + jnp.einsum('bhck,bhcv->bhkv', kt_c, v_new)
        return state, o

    b, h, dk = qc.shape[1], qc.shape[2], qc.shape[-1]
    s0 = jnp.zeros((b, h, dk, dv), f32)
    _, o = lax.scan(step, s0, (attn, u, w, q_decay, k_tail, g_total))
    return from_chunks(o)


def mlstm_chunkwise(q, k, v, i_pre, f_pre):
    f32 = jnp.float32
    qc, kc, vc = (to_chunks(t.astype(f32)) for t in (q, k, v))
    ic = to_chunks(i_pre.astype(f32))
    b_cum = jnp.cumsum(to_chunks(jax.nn.log_sigmoid(f_pre.astype(f32))), axis=-1)
    causal = jnp.tril(jnp.ones((CHUNK, CHUNK), bool))

    def step(carry, inp):
        c_state, n_state, m_state = carry
        q_c, k_c, v_c, i_c, b_c = inp
        log_d = jnp.where(causal, b_c[..., :, None] - b_c[..., None, :] + i_c[..., None, :], -jnp.inf)
        m_inter = b_c + m_state[..., None]
        m_t = jnp.maximum(m_inter, jnp.max(log_d, axis=-1))
        w_intra = jnp.exp(log_d - m_t[..., None])
        w_inter = jnp.exp(m_inter - m_t)
        s = jnp.einsum('bhid,bhjd->bhij', q_c, k_c) * w_intra
        num = (w_inter[..., None] * jnp.einsum('bhck,bhkv->bhcv', q_c, c_state)
               + jnp.einsum('bhij,bhjv->bhiv', s, v_c))
        den = w_inter * jnp.einsum('bhck,bhk->bhc', q_c, n_state) + jnp.sum(s, axis=-1)
        h = num / jnp.maximum(jnp.abs(den), jnp.exp(-m_t))[..., None]
        b_last = b_c[..., -1]
        log_end = b_last[..., None] - b_c + i_c
        m_new = jnp.maximum(b_last + m_state, jnp.max(log_end, axis=-1))
        wk = jnp.exp(log_end - m_new[..., None])
        carry_decay = jnp.exp(b_last + m_state - m_new)
        c_state = carry_decay[..., None, None] * c_state + jnp.einsum('bhc,bhck,bhcv->bhkv', wk, k_c, v_c)
        n_state = carry_decay[..., None] * n_state + jnp.einsum('bhc,bhck->bhk', wk, k_c)
        return (c_state, n_state, m_new), h

    b, h, dk, dv = qc.shape[1], qc.shape[2], qc.shape[-1], vc.shape[-1]
    init = (jnp.zeros((b, h, dk, dv), f32), jnp.zeros((b, h, dk), f32), jnp.zeros((b, h), f32))
    _, hs = lax.scan(step, init, (qc, kc, vc, ic, b_cum))
    return from_chunks(hs)


def hybrid_layer(x, c, w_ada, b_ada, norm_pre_w, w_in, gdn_conv_w, gdn_A_log, gdn_dt_bias, gdn_norm_w,
                 mlstm_conv_w, mlstm_b_i, mlstm_b_f, mlstm_norm_w, w_proj_gdn, w_proj_mlstm, w_out, norm_post_w):
    b, s, _ = x.shape
    shift, scale, gate = jnp.split(jax.nn.silu(c) @ w_ada + b_ada, 3, axis=-1)
    h = rms_norm(x, norm_pre_w) * (1.0 + scale[:, None]) + shift[:, None]
    proj = h @ w_in
    (gdn_qkv, gdn_a, gdn_b, gdn_z, ml_qk, ml_v, ml_i, ml_f, ml_o, ml_z, gate_a, gate_b) = jnp.split(
        proj, np.cumsum(IN_SPLITS)[:-1].tolist(), axis=-1)

    qkv = causal_conv_silu(gdn_qkv, gdn_conv_w)
    q_a, k_a, v_a = jnp.split(qkv, [GDN_QK_WIDTH, 2 * GDN_QK_WIDTH], axis=-1)
    rep = GDN_V_HEADS // GDN_QK_HEADS
    q_a = jnp.repeat(l2_normalize(q_a.reshape(b, s, GDN_QK_HEADS, GDN_HEAD_DIM)) * GDN_HEAD_DIM ** -0.5, rep, axis=2)
    k_a = jnp.repeat(l2_normalize(k_a.reshape(b, s, GDN_QK_HEADS, GDN_HEAD_DIM)), rep, axis=2)
    v_a = v_a.reshape(b, s, GDN_V_HEADS, GDN_HEAD_DIM)
    g_log = -jnp.exp(gdn_A_log.astype(jnp.float32)) * jax.nn.softplus(gdn_a.astype(jnp.float32) + gdn_dt_bias)
    beta = jax.nn.sigmoid(gdn_b.astype(jnp.float32))
    o_a = gated_delta_rule(q_a, k_a, v_a, g_log, beta)
    o_a = rms_norm(o_a, gdn_norm_w) * jax.nn.silu(gdn_z.astype(jnp.float32)).reshape(b, s, GDN_V_HEADS, GDN_HEAD_DIM)
    y_a = o_a.reshape(b, s, GDN_V_WIDTH).astype(x.dtype) @ w_proj_gdn

    qk = causal_conv_silu(ml_qk, mlstm_conv_w)
    q_b, k_b = jnp.split(qk, 2, axis=-1)
    q_b = q_b.reshape(b, s, MLSTM_HEADS, MLSTM_QK_DIM) * MLSTM_QK_DIM ** -0.5
    k_b = k_b.reshape(b, s, MLSTM_HEADS, MLSTM_QK_DIM)
    v_b = ml_v.reshape(b, s, MLSTM_HEADS, MLSTM_V_DIM)
    h_b = mlstm_chunkwise(q_b, k_b, v_b, ml_i + mlstm_b_i, ml_f + mlstm_b_f)
    h_b = rms_norm(h_b, mlstm_norm_w.reshape(MLSTM_HEADS, MLSTM_V_DIM)).reshape(b, s, MLSTM_V_WIDTH)
    h_b = jax.nn.sigmoid(ml_o) * h_b * jax.nn.silu(ml_z)
    y_b = h_b.astype(x.dtype) @ w_proj_mlstm

    merged = jax.nn.sigmoid(gate_a) * y_a + jax.nn.sigmoid(gate_b) * y_b
    out = merged @ w_out
    return x + gate[:, None] * rms_norm(out, norm_post_w)


def setup_inputs(seed: int = 0) -> dict:
    key = jax.random.key(seed)
    ks = jax.random.split(key, 20)
    d, f32 = D_MODEL, jnp.float32
    nrm = lambda k, shape, scale: jax.random.normal(k, shape, f32) * scale
    dt = jnp.exp(jax.random.uniform(ks[7], (DEPTH, GDN_V_HEADS), f32, np.log(1e-3), np.log(1e-1)))
    return {
        "x": nrm(ks[0], (BATCH, SEQ, d), 1.0),
        "c": nrm(ks[1], (BATCH, d), 1.0),
        "w_ada": nrm(ks[2], (DEPTH, d, 3 * d), d ** -0.5),
        "b_ada": nrm(ks[3], (DEPTH, 3 * d), 0.02),
        "norm_pre_w": 1.0 + nrm(ks[4], (DEPTH, d), 0.02),
        "w_in": nrm(ks[5], (DEPTH, d, IN_WIDTH), d ** -0.5),
        "gdn_conv_w": nrm(ks[6], (DEPTH, CONV_WIDTH, 2 * GDN_QK_WIDTH + GDN_V_WIDTH), CONV_WIDTH ** -0.5),
        "gdn_A_log": jnp.log(jax.random.uniform(ks[8], (DEPTH, GDN_V_HEADS), f32, 1.0, 16.0)),
        "gdn_dt_bias": dt + jnp.log(-jnp.expm1(-dt)),
        "gdn_norm_w": 1.0 + nrm(ks[9], (DEPTH, GDN_HEAD_DIM), 0.02),
        "mlstm_conv_w": nrm(ks[10], (DEPTH, CONV_WIDTH, 2 * MLSTM_QK_WIDTH), CONV_WIDTH ** -0.5),
        "mlstm_b_i": nrm(ks[11], (DEPTH, MLSTM_HEADS), 0.1),
        "mlstm_b_f": jnp.linspace(3.0, 6.0, MLSTM_HEADS, dtype=f32)[None] + nrm(ks[12], (DEPTH, MLSTM_HEADS), 0.1),
        "mlstm_norm_w": 1.0 + nrm(ks[13], (DEPTH, MLSTM_V_WIDTH), 0.02),
        "w_proj_gdn": nrm(ks[14], (DEPTH, GDN_V_WIDTH, d), GDN_V_WIDTH ** -0.5),
        "w_proj_mlstm": nrm(ks[15], (DEPTH, MLSTM_V_WIDTH, d), MLSTM_V_WIDTH ** -0.5),
        "w_out": nrm(ks[16], (DEPTH, d, d), d ** -0.5),
        "norm_post_w": 1.0 + nrm(ks[17], (DEPTH, d), 0.02),
    }


def reference(x, c, w_ada, b_ada, norm_pre_w, w_in, gdn_conv_w, gdn_A_log, gdn_dt_bias, gdn_norm_w,
              mlstm_conv_w, mlstm_b_i, mlstm_b_f, mlstm_norm_w, w_proj_gdn, w_proj_mlstm, w_out, norm_post_w):
    for l in range(DEPTH):
        x = hybrid_layer(x, c, w_ada[l], b_ada[l], norm_pre_w[l], w_in[l], gdn_conv_w[l], gdn_A_log[l],
                         gdn_dt_bias[l], gdn_norm_w[l], mlstm_conv_w[l], mlstm_b_i[l], mlstm_b_f[l],
                         mlstm_norm_w[l], w_proj_gdn[l], w_proj_mlstm[l], w_out[l], norm_post_w[l])
    return x
```

```cpp
#include <hip/hip_runtime.h>
#include <hip/hip_cooperative_groups.h>
#include <cstdio>
namespace cg = cooperative_groups;

#define LAS __attribute__((address_space(3)))
typedef unsigned short bf16_t;
typedef short bf16x8 __attribute__((ext_vector_type(8)));
typedef float f32x4 __attribute__((ext_vector_type(4)));
typedef float f32x2 __attribute__((ext_vector_type(2)));
typedef unsigned u32x4 __attribute__((ext_vector_type(4)));
typedef unsigned u32x2 __attribute__((ext_vector_type(2)));

constexpr int T_ = 16384, SEQ_ = 8192;
constexpr int LDP = 12288;
constexpr int N1 = 12544, N2 = 12288, INW = 24656;
constexpr int LDS_MAIN = 142336;
constexpr int LDS_BYTES = LDS_MAIN + 256;
constexpr float EPS = 1e-6f;

constexpr size_t OFF_WT1 = 0;
constexpr size_t OFF_WT2 = OFF_WT1 + (size_t)N1 * 2048 * 2;
constexpr size_t OFF_WTA = OFF_WT2 + (size_t)N2 * 2048 * 2;
constexpr size_t OFF_WTB = OFF_WTA + (size_t)2048 * 4096 * 2;
constexpr size_t OFF_WTO = OFF_WTB + (size_t)2048 * 2048 * 2;
constexpr size_t OFF_P1 = OFF_WTO + (size_t)2048 * 2048 * 2;
constexpr size_t OFF_SM = OFF_P1 + (size_t)T_ * LDP * 2;
constexpr size_t OFF_HB = OFF_SM + (size_t)T_ * 80 * 4;
constexpr size_t OFF_WB = OFF_HB + (size_t)2 * 128 * 3 * 10240 * 2;
constexpr size_t OFF_GC = OFF_WB + (size_t)T_ * 4096 * 2;
constexpr size_t OFF_MODP = OFF_GC + (size_t)T_ * 32 * 4;
constexpr size_t OFF_RSA = OFF_MODP + (size_t)8 * 2 * 6144 * 4;
constexpr size_t OFF_RSB = OFF_RSA + (size_t)T_ * 32 * 2 * 4;
constexpr size_t OFF_SSQ = OFF_RSB + (size_t)T_ * 8 * 8 * 4;
constexpr size_t OFF_BAR = OFF_SSQ + (size_t)T_ * 32 * 4;
constexpr size_t WS_NEED = OFF_BAR + 16384;

struct Params {
    const float *x, *c, *w_ada, *b_ada, *npre, *w_in, *gconv, *Alog, *dtb, *gnw, *mconv, *mbi, *mbf, *mnw, *wpa, *wpb, *wout, *npost;
    float* out;
    unsigned char* ws;
};

typedef __bf16 bf16v2_t __attribute__((ext_vector_type(2)));
__device__ __forceinline__ unsigned cvt_pk_bf16(float lo, float hi) { bf16v2_t v; v.x = (__bf16)lo; v.y = (__bf16)hi; return __builtin_bit_cast(unsigned, v); }
__device__ __forceinline__ bf16_t f2bf(float f) { return (bf16_t)(cvt_pk_bf16(f, 0.f) & 0xffffu); }
__device__ __forceinline__ float bf2f(bf16_t v) { return __uint_as_float(((unsigned)v) << 16); }
__device__ __forceinline__ float bflo(unsigned w) { return __uint_as_float(w << 16); }
__device__ __forceinline__ float bfhi(unsigned w) { return __uint_as_float(w & 0xffff0000u); }
__device__ __forceinline__ float sigmoidf_(float x) { return __builtin_amdgcn_rcpf(1.0f + __expf(-x)); }
__device__ __forceinline__ float siluf_(float x) { return x * __builtin_amdgcn_rcpf(1.0f + __expf(-x)); }
__device__ __forceinline__ f32x4 mfma16(bf16x8 a, bf16x8 b, f32x4 c) { return __builtin_amdgcn_mfma_f32_16x16x32_bf16(a, b, c, 0, 0, 0); }
__device__ __forceinline__ void unpack8(const u32x4 v, float (&f)[8]) {
    f[0] = bflo(v.x); f[1] = bfhi(v.x); f[2] = bflo(v.y); f[3] = bfhi(v.y); f[4] = bflo(v.z); f[5] = bfhi(v.z); f[6] = bflo(v.w); f[7] = bfhi(v.w);
}
__device__ __forceinline__ u32x4 pack8(const float (&f)[8]) {
    u32x4 w; w.x = cvt_pk_bf16(f[0], f[1]); w.y = cvt_pk_bf16(f[2], f[3]); w.z = cvt_pk_bf16(f[4], f[5]); w.w = cvt_pk_bf16(f[6], f[7]); return w;
}
__device__ __forceinline__ u32x2 pack4(float a, float b, float c, float d) { u32x2 w; w.x = cvt_pk_bf16(a, b); w.y = cvt_pk_bf16(c, d); return w; }
__device__ __forceinline__ float wave_scan_add(float v, int lane) {
#pragma unroll
    for (int d = 1; d < 64; d <<= 1) { float t = __shfl_up(v, d); if (lane >= d) v += t; }
    return v;
}
__device__ __forceinline__ float wave_scan_max(float v, int lane) {
#pragma unroll
    for (int d = 1; d < 64; d <<= 1) { float t = __shfl_up(v, d); if (lane >= d) v = fmaxf(v, t); }
    return v;
}
__device__ __forceinline__ float wave_sum(float v) {
#pragma unroll
    for (int d = 32; d >= 1; d >>= 1) v += __shfl_xor(v, d);
    return v;
}

namespace pg8 {
constexpr int BM = 256, BK = 64, HALF = 128, HTB = HALF * BK * 2, STAGE_BYTES = 8 * HTB, NXCD = 8, WGM = 8;
__host__ __device__ __forceinline__ int lds_byte(int r, int c) { const int st = (r >> 4) * 2 + (c >> 5), rr = r & 15, cc = c & 31, ob = rr * 64 + cc * 2; return st * 1024 + (ob ^ (((ob >> 9) & 1) << 5)); }
__host__ __device__ __forceinline__ void stage_rc(int b, int& R, int& C) { const int st = b / 1024, sb = b % 1024, swz = sb ^ (((sb >> 9) & 1) << 5); R = (st >> 1) * 16 + swz / 64; C = (st & 1) * 32 + (swz % 64) / 2; }
__host__ __device__ __forceinline__ int perm32(int rho) { const int n = rho >> 4, i = rho & 15; return 8 * (i >> 2) + 4 * n + (i & 3); }
struct Unit { int pm, pn; };
struct Gemm { const bf16_t* A; const bf16_t* Bt; int lda; int M, N, K; };
struct StaticOrder {
    int nM, nN, nwg, G, c;
    __device__ void init(int M, int N, int G_, int c_) { nM = M / BM; nN = N / BM; nwg = nM * nN; G = G_; c = c_; }
    __device__ bool next(int i, Unit& u) const {
        const long L = (long)i * G + c; if (L >= nwg) return false;
        int wgid = (int)L; { const int q = nwg / NXCD, r = nwg % NXCD, xcd = wgid % NXCD, off = wgid / NXCD; wgid = (xcd < r ? xcd * (q + 1) : r * (q + 1) + (xcd - r) * q) + off; }
        const int nig = WGM * nN, gid = wgid / nig, fm = gid * WGM, gsz = (nM - fm) < WGM ? (nM - fm) : WGM;
        u.pm = fm + ((wgid % nig) % gsz); u.pn = (wgid % nig) / gsz; return true;
    }
};
template <class Epi>
__device__ __forceinline__ void gemm_phase(LAS unsigned char* lds, const Gemm g, const StaticOrder& S, const Epi& E) {
    int tid_ = threadIdx.x; asm volatile("" : "+v"(tid_));
    const int tid = tid_, wid = __builtin_amdgcn_readfirstlane(tid >> 6), lane = tid & 63, wr = wid >> 2, wc = wid & 3, fr = lane & 15, fq = lane >> 4;
    const int K = g.K, nt = K / BK;
    unsigned voffA[2], voffB[2];
#pragma unroll
    for (int i = 0; i < 2; ++i) { int R, C; stage_rc(tid * 16 + i * 8192, R, C); const int Rb = (R & ~31) + perm32(R & 31);
        voffA[i] = (unsigned)(R * g.lda + C) * 2u; voffB[i] = (unsigned)(Rb * K + C) * 2u; }
    const size_t kstep = (size_t)(BK * 2);
    const size_t hstepA = (size_t)HALF * g.lda * 2, tstepA = 2 * hstepA;
    const size_t hstepB = (size_t)HALF * K * 2, tstepB = 2 * hstepB;
    const unsigned ldsw = (unsigned)wid * 1024u;
    const int aoff = lds_byte(wr * 64 + fr, fq * 8), boff = lds_byte(wc * 32 + fr, fq * 8);
#define PG8_SA(b, h) (((b) * 2 + (h)) * HTB)
#define PG8_SB(b, h) ((4 + (b) * 2 + (h)) * HTB)
#define PG8_STAGE(bufoff, gbase, voff) do { _Pragma("unroll") for (int _i = 0; _i < 2; ++_i) \
        __builtin_amdgcn_global_load_lds((const unsigned*)((const char*)(gbase) + (voff)[_i]), (LAS unsigned*)(lds + (bufoff) + ldsw + _i * 8192), 16, 0, 0); } while (0)
#define PG8_LDA(dst, b, h) do { _Pragma("unroll") for (int m = 0; m < 4; ++m) _Pragma("unroll") for (int k = 0; k < 2; ++k) dst[m][k] = *(const LAS bf16x8*)(lds + PG8_SA(b, h) + aoff + m * 2048 + k * 1024); } while (0)
#define PG8_LDB(dst, b, h) do { _Pragma("unroll") for (int n = 0; n < 2; ++n) _Pragma("unroll") for (int k = 0; k < 2; ++k) dst[n][k] = *(const LAS bf16x8*)(lds + PG8_SB(b, h) + boff + n * 2048 + k * 1024); } while (0)
#define PG8_MMA(ai, bj, At, Bt) do { __builtin_amdgcn_s_setprio(1); _Pragma("unroll") for (int m = 0; m < 4; ++m) _Pragma("unroll") for (int n = 0; n < 2; ++n) _Pragma("unroll") for (int k = 0; k < 2; ++k) \
        acc[ai][bj][m][n] = __builtin_amdgcn_mfma_f32_16x16x32_bf16(Bt[n][k], At[m][k], acc[ai][bj][m][n], 0, 0, 0); __builtin_amdgcn_s_setprio(0); } while (0)
#define PG8_WAIT_V(n) asm volatile("s_waitcnt vmcnt(" #n ")" ::: "memory")
#define PG8_WAIT_L(n) asm volatile("s_waitcnt lgkmcnt(" #n ")" ::: "memory")
#define PG8_BAR __builtin_amdgcn_s_barrier()
#define PG8_SCHED __builtin_amdgcn_sched_barrier(0)
    Unit cur, nxt; int ui = 0;
    if (!S.next(0, cur)) return;
    f32x4 acc[2][2][4][2];
#pragma unroll
    for (int a = 0; a < 2; ++a)
#pragma unroll
        for (int b = 0; b < 2; ++b)
#pragma unroll
            for (int m = 0; m < 4; ++m)
#pragma unroll
                for (int n = 0; n < 2; ++n) acc[a][b][m][n] = (f32x4){0.f, 0.f, 0.f, 0.f};
    bf16x8 At[4][2], B0[2][2], B1[2][2];
    const char* cA = (const char*)g.A + (size_t)cur.pm * tstepA; const char* cB = (const char*)g.Bt + (size_t)cur.pn * tstepB;
    PG8_STAGE(PG8_SB(0, 0), cB, voffB); PG8_STAGE(PG8_SA(0, 0), cA, voffA); PG8_STAGE(PG8_SB(0, 1), cB + hstepB, voffB); PG8_STAGE(PG8_SA(0, 1), cA + hstepA, voffA);
    if (wr == 1) PG8_BAR;
    PG8_WAIT_V(4); PG8_BAR;
    PG8_STAGE(PG8_SB(1, 0), cB + kstep, voffB); PG8_STAGE(PG8_SA(1, 0), cA + kstep, voffA); PG8_STAGE(PG8_SB(1, 1), cB + hstepB + kstep, voffB);
    PG8_WAIT_V(6); PG8_BAR;
    for (;;) {
        const bool has_next = S.next(ui + 1, nxt);
        const char* nA = has_next ? (const char*)g.A + (size_t)nxt.pm * tstepA : cA; const char* nB = has_next ? (const char*)g.Bt + (size_t)nxt.pn * tstepB : cB;
        for (int t = 0; t < nt; t += 2) {
            const bool last = (t == nt - 2);
            const char* a1 = cA + (size_t)(t + 1) * kstep;
            const char* a2 = last ? nA : cA + (size_t)(t + 2) * kstep; const char* b2 = last ? nB : cB + (size_t)(t + 2) * kstep;
            const char* a3 = a2 + kstep; const char* b3 = b2 + kstep;
            PG8_LDB(B0, 0, 0); PG8_SCHED; PG8_LDA(At, 0, 0); PG8_STAGE(PG8_SA(1, 1), a1 + hstepA, voffA);
            PG8_WAIT_L(8); PG8_BAR; PG8_WAIT_L(0); PG8_MMA(0, 0, At, B0); PG8_BAR; PG8_SCHED;
            PG8_LDB(B1, 0, 1); PG8_STAGE(PG8_SB(0, 0), b2, voffB);
            PG8_BAR; PG8_WAIT_L(0); PG8_MMA(0, 1, At, B1); PG8_BAR;
            PG8_LDA(At, 0, 1); PG8_STAGE(PG8_SA(0, 0), a2, voffA);
            PG8_BAR; PG8_WAIT_L(0); PG8_MMA(1, 0, At, B0); PG8_BAR; PG8_SCHED;
            PG8_STAGE(PG8_SB(0, 1), b2 + hstepB, voffB);
            PG8_WAIT_V(6); PG8_BAR; PG8_MMA(1, 1, At, B1); PG8_BAR;
            PG8_LDB(B0, 1, 0); PG8_SCHED; PG8_LDA(At, 1, 0); PG8_STAGE(PG8_SA(0, 1), a2 + hstepA, voffA);
            PG8_WAIT_L(8); PG8_BAR; PG8_WAIT_L(0); PG8_MMA(0, 0, At, B0); PG8_BAR; PG8_SCHED;
            PG8_LDB(B1, 1, 1); PG8_STAGE(PG8_SB(1, 0), b3, voffB);
            PG8_BAR; PG8_WAIT_L(0); PG8_MMA(0, 1, At, B1); PG8_BAR;
            PG8_LDA(At, 1, 1); PG8_STAGE(PG8_SA(1, 0), a3, voffA);
            PG8_BAR; PG8_WAIT_L(0); PG8_MMA(1, 0, At, B0); PG8_BAR; PG8_SCHED;
            PG8_STAGE(PG8_SB(1, 1), b3 + hstepB, voffB);
            PG8_WAIT_V(6); PG8_BAR; PG8_MMA(1, 1, At, B1); PG8_BAR;
        }
        E(acc, cur, wr, wc, fr, fq);
        if (!has_next) break;
#pragma unroll
        for (int a = 0; a < 2; ++a)
#pragma unroll
            for (int b = 0; b < 2; ++b)
#pragma unroll
                for (int m = 0; m < 4; ++m)
#pragma unroll
                    for (int n = 0; n < 2; ++n) acc[a][b][m][n] = (f32x4){0.f, 0.f, 0.f, 0.f};
        cur = nxt; cA = nA; cB = nB; ++ui;
    }
    PG8_WAIT_V(0);
    if (wr == 0) PG8_BAR;
    PG8_BAR;
#undef PG8_SA
#undef PG8_SB
#undef PG8_STAGE
#undef PG8_LDA
#undef PG8_LDB
#undef PG8_MMA
#undef PG8_WAIT_V
#undef PG8_WAIT_L
#undef PG8_BAR
#undef PG8_SCHED
}
}

typedef f32x4 AccT[2][2][4][2];

struct Epi1 {
    bf16_t* P1; bf16_t* HB; float* SM;
    __device__ __forceinline__ void operator()(const AccT& acc, const pg8::Unit& u, int wr, int wc, int fr, int fq) const {
        if (u.pn < 48) {
#pragma unroll
            for (int ai = 0; ai < 2; ++ai)
#pragma unroll
                for (int m = 0; m < 4; ++m) {
                    const int row = u.pm * 256 + ai * 128 + wr * 64 + m * 16 + fr;
#pragma unroll
                    for (int bj = 0; bj < 2; ++bj) {
                        const int col = u.pn * 256 + bj * 128 + wc * 32 + 8 * fq;
                        const f32x4 v0 = acc[ai][bj][m][0], v1 = acc[ai][bj][m][1];
                        u32x4 w; w.x = cvt_pk_bf16(v0[0], v0[1]); w.y = cvt_pk_bf16(v0[2], v0[3]); w.z = cvt_pk_bf16(v1[0], v1[1]); w.w = cvt_pk_bf16(v1[2], v1[3]);
                        *(u32x4*)(P1 + (size_t)row * LDP + col) = w;
                        if (m == 3 && fr >= 13 && u.pn < 40) {
                            const int b = row >> 13, ch = (row & 8191) >> 6;
                            *(u32x4*)(HB + ((size_t)(b * 128 + ch) * 3 + (fr - 13)) * 10240 + col) = w;
                        }
                    }
                }
        } else {
#pragma unroll
            for (int ai = 0; ai < 2; ++ai)
#pragma unroll
                for (int m = 0; m < 4; ++m) {
                    const int row = u.pm * 256 + ai * 128 + wr * 64 + m * 16 + fr;
#pragma unroll
                    for (int bj = 0; bj < 2; ++bj) {
                        const int lc = bj * 128 + wc * 32 + 8 * fq;
                        if (lc < 80) {
#pragma unroll
                            for (int e = 0; e < 4; ++e) { SM[(size_t)(lc + e) * T_ + row] = acc[ai][bj][m][0][e]; SM[(size_t)(lc + 4 + e) * T_ + row] = acc[ai][bj][m][1][e]; }
                        }
                    }
                }
        }
    }
};

struct Epi2 {
    bf16_t* P1; const float* RSA; const float* RSB; const float* gnw; const float* mnw;
    __device__ __forceinline__ void operator()(const AccT& acc, const pg8::Unit& u, int wr, int wc, int fr, int fq) const {
        if (u.pn < 16) {
            f32x4 nwv[2][2];
#pragma unroll
            for (int bj = 0; bj < 2; ++bj) { const int ch = (bj * 128 + wc * 32 + 8 * fq) & 127; nwv[bj][0] = *(const f32x4*)(gnw + ch); nwv[bj][1] = *(const f32x4*)(gnw + ch + 4); }
#pragma unroll
            for (int ai = 0; ai < 2; ++ai) {
                u32x4 ov[4][2]; f32x2 pp[4][2];
#pragma unroll
                for (int m = 0; m < 4; ++m)
#pragma unroll
                    for (int bj = 0; bj < 2; ++bj) {
                        const int row = u.pm * 256 + ai * 128 + wr * 64 + m * 16 + fr;
                        const int gc = u.pn * 256 + bj * 128 + wc * 32 + 8 * fq, head = gc >> 7;
                        ov[m][bj] = *(const u32x4*)(P1 + (size_t)row * LDP + 4096 + gc);
                        { const int bb_ = row >> 13, ts_ = row & 8191; pp[m][bj].x = RSA[(size_t)((bb_ * 32 + head) * 2) * SEQ_ + ts_]; pp[m][bj].y = RSA[(size_t)((bb_ * 32 + head) * 2 + 1) * SEQ_ + ts_]; }
                    }
#pragma unroll
                for (int m = 0; m < 4; ++m)
#pragma unroll
                    for (int bj = 0; bj < 2; ++bj) {
                        const int row = u.pm * 256 + ai * 128 + wr * 64 + m * 16 + fr;
                        const int gc = u.pn * 256 + bj * 128 + wc * 32 + 8 * fq;
                        const float rstd = rsqrtf((pp[m][bj].x + pp[m][bj].y) * (1.0f / 128.0f) + EPS);
                        float o[8]; unpack8(ov[m][bj], o);
                        const f32x4 z0 = acc[ai][bj][m][0], z1 = acc[ai][bj][m][1];
                        float r[8];
#pragma unroll
                        for (int e = 0; e < 4; ++e) { r[e] = o[e] * rstd * nwv[bj][0][e] * siluf_(z0[e]); r[4 + e] = o[4 + e] * rstd * nwv[bj][1][e] * siluf_(z1[e]); }
                        *(u32x4*)(P1 + (size_t)row * LDP + 4096 + gc) = pack8(r);
                    }
                asm volatile("" ::: "memory");
            }
        } else if (u.pn < 32) {
            const int q = u.pn - 16;
            const int cc = q * 128 + wc * 32 + 8 * fq, head = cc >> 8;
            const f32x4 nw0 = *(const f32x4*)(mnw + cc), nw1 = *(const f32x4*)(mnw + cc + 4);
#pragma unroll
            for (int ai = 0; ai < 2; ++ai) {
                u32x4 ov[4]; f32x4 p0[4], p1[4];
#pragma unroll
                for (int m = 0; m < 4; ++m) {
                    const int row = u.pm * 256 + ai * 128 + wr * 64 + m * 16 + fr;
                    ov[m] = *(const u32x4*)(P1 + (size_t)row * LDP + 10240 + cc);
                    { const int bb_ = row >> 13, ts_ = row & 8191; const float* rb_ = RSB + (size_t)((bb_ * 8 + head) * 8) * SEQ_ + ts_;
#pragma unroll
                      for (int k_ = 0; k_ < 4; ++k_) { p0[m][k_] = rb_[(size_t)k_ * SEQ_]; p1[m][k_] = rb_[(size_t)(4 + k_) * SEQ_]; } }
                }
#pragma unroll
                for (int m = 0; m < 4; ++m) {
                    const int row = u.pm * 256 + ai * 128 + wr * 64 + m * 16 + fr;
                    const float ss = (p0[m][0] + p0[m][1]) + (p0[m][2] + p0[m][3]) + (p1[m][0] + p1[m][1]) + (p1[m][2] + p1[m][3]);
                    const float rstd = rsqrtf(ss * (1.0f / 256.0f) + EPS);
                    float o[8]; unpack8(ov[m], o);
                    const f32x4 g0 = acc[ai][0][m][0], g1 = acc[ai][0][m][1], z0 = acc[ai][1][m][0], z1 = acc[ai][1][m][1];
                    float r[8];
#pragma unroll
                    for (int e = 0; e < 4; ++e) { r[e] = sigmoidf_(g0[e]) * o[e] * rstd * nw0[e] * siluf_(z0[e]); r[4 + e] = sigmoidf_(g1[e]) * o[4 + e] * rstd * nw1[e] * siluf_(z1[e]); }
                    *(u32x4*)(P1 + (size_t)row * LDP + 10240 + cc) = pack8(r);
                }
                asm volatile("" ::: "memory");
            }
        } else {
#pragma unroll
            for (int ai = 0; ai < 2; ++ai)
#pragma unroll
                for (int m = 0; m < 4; ++m) {
                    const int row = u.pm * 256 + ai * 128 + wr * 64 + m * 16 + fr;
#pragma unroll
                    for (int bj = 0; bj < 2; ++bj) {
                        const int col = (u.pn - 32) * 256 + bj * 128 + wc * 32 + 8 * fq;
                        const f32x4 v0 = acc[ai][bj][m][0], v1 = acc[ai][bj][m][1];
                        float r[8];
#pragma unroll
                        for (int e = 0; e < 4; ++e) { r[e] = sigmoidf_(v0[e]); r[4 + e] = sigmoidf_(v1[e]); }
                        *(u32x4*)(P1 + (size_t)row * LDP + col) = pack8(r);
                    }
                }
        }
    }
};

struct EpiA {
    const bf16_t* P1; float* tmp;
    __device__ __forceinline__ void operator()(const AccT& acc, const pg8::Unit& u, int wr, int wc, int fr, int fq) const {
#pragma unroll
        for (int ai = 0; ai < 2; ++ai) {
            u32x4 sv[4][2];
#pragma unroll
            for (int m = 0; m < 4; ++m)
#pragma unroll
                for (int bj = 0; bj < 2; ++bj) {
                    const int row = u.pm * 256 + ai * 128 + wr * 64 + m * 16 + fr, col = u.pn * 256 + bj * 128 + wc * 32 + 8 * fq;
                    sv[m][bj] = *(const u32x4*)(P1 + (size_t)row * LDP + col);
                }
#pragma unroll
            for (int m = 0; m < 4; ++m)
#pragma unroll
                for (int bj = 0; bj < 2; ++bj) {
                    const int row = u.pm * 256 + ai * 128 + wr * 64 + m * 16 + fr, col = u.pn * 256 + bj * 128 + wc * 32 + 8 * fq;
                    float s[8]; unpack8(sv[m][bj], s);
                    const f32x4 v0 = acc[ai][bj][m][0], v1 = acc[ai][bj][m][1];
                    float r[8];
#pragma unroll
                    for (int e = 0; e < 4; ++e) { r[e] = s[e] * v0[e]; r[4 + e] = s[4 + e] * v1[e]; }
                    *(u32x4*)((bf16_t*)tmp + (size_t)row * 2048 + col) = pack8(r);
                }
            asm volatile("" ::: "memory");
        }
    }
};
struct EpiB {
    bf16_t* P1; const float* tmp;
    __device__ __forceinline__ void operator()(const AccT& acc, const pg8::Unit& u, int wr, int wc, int fr, int fq) const {
#pragma unroll
        for (int ai = 0; ai < 2; ++ai)
#pragma unroll
            for (int mh = 0; mh < 2; ++mh) {
                u32x4 sv[2][2], tv[2][2];
#pragma unroll
                for (int mm = 0; mm < 2; ++mm)
#pragma unroll
                    for (int bj = 0; bj < 2; ++bj) {
                        const int m = mh * 2 + mm;
                        const int row = u.pm * 256 + ai * 128 + wr * 64 + m * 16 + fr, col = u.pn * 256 + bj * 128 + wc * 32 + 8 * fq;
                        sv[mm][bj] = *(const u32x4*)(P1 + (size_t)row * LDP + 2048 + col);
                        tv[mm][bj] = *(const u32x4*)((const bf16_t*)tmp + (size_t)row * 2048 + col);
                    }
#pragma unroll
                for (int mm = 0; mm < 2; ++mm)
#pragma unroll
                    for (int bj = 0; bj < 2; ++bj) {
                        const int m = mh * 2 + mm;
                        const int row = u.pm * 256 + ai * 128 + wr * 64 + m * 16 + fr, col = u.pn * 256 + bj * 128 + wc * 32 + 8 * fq;
                        float s[8], t[8]; unpack8(sv[mm][bj], s); unpack8(tv[mm][bj], t);
                        const f32x4 v0 = acc[ai][bj][m][0], v1 = acc[ai][bj][m][1];
                        float r[8];
#pragma unroll
                        for (int e = 0; e < 4; ++e) { r[e] = t[e] + s[e] * v0[e]; r[4 + e] = t[4 + e] + s[4 + e] * v1[e]; }
                        *(u32x4*)(P1 + (size_t)row * LDP + 8192 + col) = pack8(r);
                    }
                asm volatile("" ::: "memory");
            }
    }
};
struct EpiO {
    float* OUTF; float* SSQ;
    __device__ __forceinline__ void operator()(const AccT& acc, const pg8::Unit& u, int wr, int wc, int fr, int fq) const {
#pragma unroll
        for (int ai = 0; ai < 2; ++ai)
#pragma unroll
            for (int m = 0; m < 4; ++m) {
                const int row = u.pm * 256 + ai * 128 + wr * 64 + m * 16 + fr;
                float s = 0.f;
#pragma unroll
                for (int bj = 0; bj < 2; ++bj) {
                    const int col = u.pn * 256 + bj * 128 + wc * 32 + 8 * fq;
                    const f32x4 v0 = acc[ai][bj][m][0], v1 = acc[ai][bj][m][1];
                    u32x4 wv; wv.x = cvt_pk_bf16(v0[0], v0[1]); wv.y = cvt_pk_bf16(v0[2], v0[3]); wv.z = cvt_pk_bf16(v1[0], v1[1]); wv.w = cvt_pk_bf16(v1[2], v1[3]);
                    *(u32x4*)((bf16_t*)OUTF + (size_t)row * 2048 + col) = wv;
#pragma unroll
                    for (int e = 0; e < 4; ++e) s += v0[e] * v0[e] + v1[e] * v1[e];
                }
                s += __shfl_xor(s, 16); s += __shfl_xor(s, 32);
                if (fq == 0) SSQ[(size_t)row * 32 + u.pn * 4 + wc] = s;
            }
    }
};

__device__ __forceinline__ int orig1(int n) {
    if (n < 8192) return n;
    if (n < 10240) return 12352 + (n - 8192);
    if (n < 12288) return 14400 + (n - 10240);
    const int j = n - 12288;
    if (j < 64) return 8192 + j;
    if (j < 80) return 16448 + (j - 64);
    return -1;
}
__device__ __forceinline__ int orig2(int n) {
    if (n < 4096) return 8256 + n;
    if (n < 8192) { const int q = (n - 4096) >> 8, l = (n - 4096) & 255; return l < 128 ? 16464 + 128 * q + l : 18512 + 128 * q + (l - 128); }
    if (n < 10240) return 20560 + (n - 8192);
    return 22608 + (n - 10240);
}
__device__ void transpose_tile(const float* __restrict__ W, int ldw, int K, bf16_t* __restrict__ Wt, int n0, int k0, int which, float* tl) {
    const int tid = threadIdx.x;
    const int nn = (tid & 31) * 4, n = n0 + nn;
    const int oc = which == 1 ? orig1(n) : (which == 2 ? orig2(n) : n);
    f32x4 v[8];
#pragma unroll
    for (int pass = 0; pass < 8; ++pass) {
        const int kk = (tid >> 5) + 16 * pass;
        v[pass] = (f32x4){0.f, 0.f, 0.f, 0.f};
        if (oc >= 0) v[pass] = *(const f32x4*)(W + (size_t)(k0 + kk) * ldw + oc);
    }
#pragma unroll
    for (int pass = 0; pass < 8; ++pass) {
        const int kk = (tid >> 5) + 16 * pass;
        tl[kk * 129 + nn] = v[pass][0]; tl[kk * 129 + nn + 1] = v[pass][1]; tl[kk * 129 + nn + 2] = v[pass][2]; tl[kk * 129 + nn + 3] = v[pass][3];
    }
    __syncthreads();
#pragma unroll
    for (int r = 0; r < 4; ++r) {
        const int pce = tid + 512 * r, nl = pce >> 4, kg = pce & 15;
        float f[8];
#pragma unroll
        for (int e = 0; e < 8; ++e) f[e] = tl[(kg * 8 + e) * 129 + nl];
        *(u32x4*)(Wt + (size_t)(n0 + nl) * K + k0 + kg * 8) = pack8(f);
    }
    __syncthreads();
}

__device__ void phase0(const Params& p, unsigned char* smem) {
    float* tl = (float*)smem;
    int tid_ = threadIdx.x; asm volatile("" : "+v"(tid_));
    const int tid = tid_;
    bf16_t* WT1 = (bf16_t*)(p.ws + OFF_WT1); bf16_t* WT2 = (bf16_t*)(p.ws + OFF_WT2);
    bf16_t* WTA = (bf16_t*)(p.ws + OFF_WTA); bf16_t* WTB = (bf16_t*)(p.ws + OFF_WTB); bf16_t* WTO = (bf16_t*)(p.ws + OFF_WTO);
    float* MODP = (float*)(p.ws + OFF_MODP);
    constexpr int NT1 = (N1 / 128) * 16, NT2 = (N2 / 128) * 16, NTA = 16 * 32, NTB = 16 * 16, NTO = 16 * 16, NADA = 192;
    constexpr int NU = NADA + NT1;
    for (int u = blockIdx.x; u < NU; u += gridDim.x) {
        if (u < NADA) {
            const int cb = u % 24, ks = u / 24;
            float* sl = tl;
            float* red = tl + 512;
            __syncthreads();
            { const int bb = tid >> 8, kk = tid & 255; sl[tid] = siluf_(p.c[bb * 2048 + ks * 256 + kk]); }
            __syncthreads();
            const int col = cb * 256 + (tid & 255), half = tid >> 8;
            float a0 = 0.f, a1 = 0.f;
            const float* wp = p.w_ada + (size_t)(ks * 256 + half * 128) * 6144 + col;
#pragma unroll 8
            for (int i = 0; i < 128; ++i) { const float w = wp[(size_t)i * 6144]; a0 += sl[half * 128 + i] * w; a1 += sl[256 + half * 128 + i] * w; }
            if (half == 1) { red[tid & 255] = a0; red[256 + (tid & 255)] = a1; }
            __syncthreads();
            if (half == 0) { MODP[(ks * 2 + 0) * 6144 + col] = a0 + red[tid]; MODP[(ks * 2 + 1) * 6144 + col] = a1 + red[256 + tid]; }
            __syncthreads();
        } else {
            int t = u - NADA;
            transpose_tile(p.w_in, INW, 2048, WT1, (t >> 4) * 128, (t & 15) * 128, 1, tl);
        }
    }
    (void)WT2; (void)WTA; (void)WTB; (void)WTO; (void)NT2; (void)NTA; (void)NTB; (void)NTO;
}

__device__ void late_transposes(const Params& p, unsigned char* smem, int idx, int nblk) {
    float* tl = (float*)smem;
    bf16_t* WT2 = (bf16_t*)(p.ws + OFF_WT2);
    bf16_t* WTA = (bf16_t*)(p.ws + OFF_WTA); bf16_t* WTB = (bf16_t*)(p.ws + OFF_WTB); bf16_t* WTO = (bf16_t*)(p.ws + OFF_WTO);
    constexpr int NT2 = (N2 / 128) * 16, NTA = 16 * 32, NTB = 16 * 16, NTO = 16 * 16;
    __syncthreads();
    for (int u = idx; u < NT2 + NTA + NTB + NTO; u += nblk) {
        int t = u;
        if (t < NT2) { transpose_tile(p.w_in, INW, 2048, WT2, (t >> 4) * 128, (t & 15) * 128, 2, tl); continue; }
        t -= NT2;
        if (t < NTA) { transpose_tile(p.wpa, 2048, 4096, WTA, (t >> 5) * 128, (t & 31) * 128, 0, tl); continue; }
        t -= NTA;
        if (t < NTB) { transpose_tile(p.wpb, 2048, 2048, WTB, (t >> 4) * 128, (t & 15) * 128, 0, tl); continue; }
        t -= NTB;
        transpose_tile(p.wout, 2048, 2048, WTO, (t >> 4) * 128, (t & 15) * 128, 0, tl);
    }
}

__device__ void phase1(const Params& p, unsigned char* smem) {
    float* shl = (float*)smem;
    float* scl = shl + 2048;
    const float* MODP = (const float*)(p.ws + OFF_MODP);
    bf16_t* H = (bf16_t*)p.out;
    int tid_ = threadIdx.x; asm volatile("" : "+v"(tid_));
    const int tid = tid_, lane = tid & 63, w = tid >> 6;
    for (int blk = blockIdx.x; blk < T_ / 64; blk += gridDim.x) {
        const int b = (blk * 64) >> 13;
        __syncthreads();
        for (int col = tid; col < 2048; col += 512) {
            float s0 = p.b_ada[col], s1 = 1.0f + p.b_ada[2048 + col];
#pragma unroll
            for (int ks = 0; ks < 8; ++ks) { s0 += MODP[(ks * 2 + b) * 6144 + col]; s1 += MODP[(ks * 2 + b) * 6144 + 2048 + col]; }
            shl[col] = s0; scl[col] = s1;
        }
        __syncthreads();
#pragma unroll 2
        for (int i = 0; i < 8; ++i) {
            const int row = blk * 64 + w * 8 + i;
            const float* xr = p.x + (size_t)row * 2048;
            f32x4 v[8]; float ss = 0.f;
#pragma unroll
            for (int e = 0; e < 8; ++e) { v[e] = *(const f32x4*)(xr + lane * 4 + 256 * e); ss += v[e][0] * v[e][0] + v[e][1] * v[e][1] + v[e][2] * v[e][2] + v[e][3] * v[e][3]; }
            ss = wave_sum(ss);
            const float rstd = rsqrtf(ss * (1.0f / 2048.0f) + EPS);
#pragma unroll
            for (int e = 0; e < 8; ++e) {
                const int col = lane * 4 + 256 * e;
                const f32x4 nw = *(const f32x4*)(p.npre + col), sh = *(const f32x4*)(shl + col), sc = *(const f32x4*)(scl + col);
                float r[4];
#pragma unroll
                for (int k = 0; k < 4; ++k) r[k] = v[e][k] * rstd * nw[k] * sc[k] + sh[k];
                *(u32x2*)(H + (size_t)row * 2048 + col) = pack4(r[0], r[1], r[2], r[3]);
            }
        }
    }
}

__device__ __forceinline__ void conv_item(const bf16_t* P1, const bf16_t* HB, int b, int c, int t, int col, const float* cw  , int cwstride, float (&y)[8]) {
    const size_t row0 = (size_t)b * SEQ_ + (size_t)c * 64;
    u32x4 xv[4];
    const int cp = c > 0 ? c - 1 : 0;
#pragma unroll
    for (int j = 0; j < 4; ++j) {
        const int tt = t - 3 + j;
        const bf16_t* src = (tt >= 0) ? (P1 + (row0 + tt) * LDP + col) : (HB + ((size_t)(b * 128 + cp) * 3 + (tt + 3)) * 10240 + col);
        xv[j] = *(const u32x4*)src;
        if (tt < 0 && c == 0) xv[j] = (u32x4){0u, 0u, 0u, 0u};
    }
#pragma unroll
    for (int e = 0; e < 8; ++e) y[e] = 0.f;
#pragma unroll
    for (int j = 0; j < 4; ++j) {
        float xf[8]; unpack8(xv[j], xf);
        const f32x4 w0 = *(const f32x4*)(cw + j * cwstride), w1 = *(const f32x4*)(cw + j * cwstride + 4);
#pragma unroll
        for (int e = 0; e < 4; ++e) { y[e] += xf[e] * w0[e]; y[4 + e] += xf[4 + e] * w1[e]; }
    }
#pragma unroll
    for (int e = 0; e < 8; ++e) y[e] = siluf_(y[e]);
}

__device__ void prep_gdn(const Params& p, unsigned char* smem, int unit0) {
    bf16_t* P1 = (bf16_t*)(p.ws + OFF_P1); const bf16_t* HB = (const bf16_t*)(p.ws + OFF_HB);
    const float* SM = (const float*)(p.ws + OFF_SM); bf16_t* WB = (bf16_t*)(p.ws + OFF_WB); float* GC = (float*)(p.ws + OFF_GC);
    bf16_t* AT = (bf16_t*)p.out + (size_t)T_ * 2048;
    int tid_ = threadIdx.x; asm volatile("" : "+v"(tid_));
    const int tid = tid_, hb = tid >> 8, ht = tid & 255, lane = tid & 63, wl = (tid >> 6) & 3, l15 = lane & 15, quad = lane >> 4;
    float* cwl = (float*)smem;
    unsigned char* hbase = smem + 4096 + hb * 69120;
    bf16_t* Qn = (bf16_t*)hbase;
    bf16_t* Kn = Qn + 64 * 136;
    float* KKl = (float*)(Kn + 64 * 136);
    float* QKl = KKl + 64 * 64;
    float* gcl = QKl + 64 * 64;
    float* btl = gcl + 128;
    float* btg = btl + 128;
    const int unit = unit0 + hb;
    const int c = unit & 127, qkh = (unit >> 7) & 15, b = unit >> 11;
    const size_t row0 = (size_t)b * SEQ_ + (size_t)c * 64;
    const int hs = ht >> 7, js = ht & 127, hsol = qkh * 2 + hs;
    bf16_t xrw[67];
    float cw0, cw1, cw2, cw3;
    {
        const int col = 4096 + hsol * 128 + js;
#pragma unroll
        for (int tt = 0; tt < 3; ++tt) xrw[tt] = c > 0 ? HB[((size_t)(b * 128 + (c - 1)) * 3 + tt) * 10240 + col] : (bf16_t)0;
#pragma unroll
        for (int tt = 0; tt < 64; ++tt) xrw[3 + tt] = P1[(row0 + tt) * LDP + col];
        cw0 = p.gconv[col]; cw1 = p.gconv[8192 + col]; cw2 = p.gconv[2 * 8192 + col]; cw3 = p.gconv[3 * 8192 + col];
    }
    __syncthreads();
    for (int i = tid; i < 1024; i += 512) { const int j = i >> 8, ch = i & 255; cwl[i] = p.gconv[(size_t)j * 8192 + (ch >> 7) * 2048 + qkh * 128 + (ch & 127)]; }
    __syncthreads();
#pragma unroll
    for (int r = 0; r < 8; ++r) {
        const int item = ht + 256 * r, chg = item & 15, t = (item >> 4) & 63, which = item >> 10;
        float y[8];
        conv_item(P1, HB, b, c, t, which * 2048 + qkh * 128 + chg * 8, cwl + which * 128 + chg * 8, 256, y);
        float ss = 0.f;
#pragma unroll
        for (int e = 0; e < 8; ++e) ss += y[e] * y[e];
        ss += __shfl_xor(ss, 1); ss += __shfl_xor(ss, 2); ss += __shfl_xor(ss, 4); ss += __shfl_xor(ss, 8);
        const float sc = rsqrtf(ss + EPS) * (which == 0 ? 0.08838834764831845f : 1.0f);
#pragma unroll
        for (int e = 0; e < 8; ++e) y[e] *= sc;
        *(u32x4*)((which == 0 ? Qn : Kn) + t * 136 + chg * 8) = pack8(y);
    }
    if (wl < 2) {
        const int h = qkh * 2 + wl;
        const float ap = SM[(size_t)h * T_ + row0 + lane], bp = SM[(size_t)(32 + h) * T_ + row0 + lane];
        const float xx = ap + p.dtb[h];
        const float sp = fmaxf(xx, 0.f) + log1pf(expf(-fabsf(xx)));
        const float g = -expf(p.Alog[h]) * sp;
        const float gcum = wave_scan_add(g, lane);
        const float beta_ = sigmoidf_(bp);
        gcl[wl * 64 + lane] = gcum; btl[wl * 64 + lane] = beta_; btg[wl * 64 + lane] = beta_ * __expf(gcum);
        GC[(size_t)(b * 32 + h) * SEQ_ + c * 64 + lane] = gcum;
    }
    __syncthreads();
#pragma unroll
    for (int i = 0; i < 8; ++i) {
        const int idx = wl * 8 + i, mat = idx >> 4, ti = (idx >> 2) & 3, tj = idx & 3;
        const bf16_t* Am = mat ? Qn : Kn;
        f32x4 a = (f32x4){0.f, 0.f, 0.f, 0.f};
#pragma unroll
        for (int kk = 0; kk < 4; ++kk) {
            const bf16x8 af = *(const bf16x8*)(Am + (16 * ti + l15) * 136 + kk * 32 + quad * 8);
            const bf16x8 bf = *(const bf16x8*)(Kn + (16 * tj + l15) * 136 + kk * 32 + quad * 8);
            a = mfma16(af, bf, a);
        }
        float* dst = mat ? QKl : KKl;
#pragma unroll
        for (int j = 0; j < 4; ++j) dst[(16 * ti + quad * 4 + j) * 64 + 16 * tj + l15] = a[j];
    }
    __syncthreads();
    {
        const int j = ht & 63;
        const float g0j = gcl[j], g1j = gcl[64 + j];
        bf16_t* atp0 = AT + ((size_t)(b * 32 + qkh * 2) * 128 + c) * 4096;
        bf16_t* atp1 = atp0 + (size_t)128 * 4096;
#pragma unroll
        for (int r = 0; r < 16; ++r) {
            const int i = (ht >> 6) + 4 * r;
            const float kk = KKl[i * 64 + j], qk = QKl[i * 64 + j];
            const float d0 = __expf(fminf(gcl[i] - g0j, 0.f)), d1 = __expf(fminf(gcl[64 + i] - g1j, 0.f));
            KKl[i * 64 + j] = (j < i) ? btl[i] * kk * d0 : 0.f;
            QKl[i * 64 + j] = (j < i) ? btl[64 + i] * kk * d1 : 0.f;
            atp0[i * 64 + j] = f2bf((j <= i) ? qk * d0 : 0.f);
            atp1[i * 64 + j] = f2bf((j <= i) ? qk * d1 : 0.f);
        }
    }
    f32x2 sol[64];
    {
        const float* bts = btl + hs * 64; const float* bgs = btg + hs * 64;
#pragma unroll
        for (int t = 0; t < 64; ++t) {
            const float y = cw0 * bf2f(xrw[t]) + cw1 * bf2f(xrw[t + 1]) + cw2 * bf2f(xrw[t + 2]) + cw3 * bf2f(xrw[t + 3]);
            sol[t].x = siluf_(y) * bts[t];
            sol[t].y = bf2f(Kn[t * 136 + js]) * bgs[t];
        }
    }
    __syncthreads();
    {
        const float* Ah = KKl + hs * 4096;
#pragma unroll
        for (int i = 1; i < 64; ++i) {
            f32x4 av[16];
#pragma unroll
            for (int j4 = 0; j4 < (i + 3) / 4; ++j4) av[j4] = *(const f32x4*)(Ah + i * 64 + j4 * 4);
            f32x2 s0 = sol[i], s1 = (f32x2){0.f, 0.f};
#pragma unroll
            for (int j4 = 0; j4 < (i + 3) / 4; ++j4) {
                s0 -= (f32x2){av[j4][0], av[j4][0]} * sol[j4 * 4 + 0]; s1 -= (f32x2){av[j4][1], av[j4][1]} * sol[j4 * 4 + 1];
                s0 -= (f32x2){av[j4][2], av[j4][2]} * sol[j4 * 4 + 2]; s1 -= (f32x2){av[j4][3], av[j4][3]} * sol[j4 * 4 + 3];
            }
            sol[i] = s0 + s1;
        }
        bf16_t* du = P1 + row0 * LDP + 4096 + hsol * 128 + js;
        bf16_t* dw = WB + row0 * 4096 + hsol * 128 + js;
#pragma unroll
        for (int t = 0; t < 64; ++t) { du[(size_t)t * LDP] = f2bf(sol[t].x); dw[(size_t)t * 4096] = f2bf(sol[t].y); if ((t & 7) == 7) asm volatile("" ::: "memory"); }
    }
#pragma unroll
    for (int r = 0; r < 4; ++r) {
        const int pce = ht + 256 * r;
        { const int t = pce >> 4, seg = pce & 15; *(u32x4*)(P1 + (row0 + t) * LDP + qkh * 128 + seg * 8) = *(const u32x4*)(Qn + t * 136 + seg * 8); }
        { const int dk = pce >> 3, t0 = (pce & 7) * 8;
          float f[8];
#pragma unroll
          for (int e = 0; e < 8; ++e) f[e] = bf2f(Kn[(t0 + e) * 136 + dk]);
          *(u32x4*)(P1 + (row0 + (pce >> 4)) * LDP + 2048 + qkh * 128 + (pce & 15) * 8) = pack8(f); }
    }
}

__device__ void prep_mlstm(const Params& p, unsigned char* smem, int unit0) {
    bf16_t* P1 = (bf16_t*)(p.ws + OFF_P1); const bf16_t* HB = (const bf16_t*)(p.ws + OFF_HB); const float* SM = (const float*)(p.ws + OFF_SM);
    bf16_t* KT = (bf16_t*)(p.ws + OFF_WT1);
    f32x4* MS = (f32x4*)(p.ws + OFF_WT1 + 33554432);
    int tid_ = threadIdx.x; asm volatile("" : "+v"(tid_));
    const int tid = tid_, hb = tid >> 8, ht = tid & 255, lane = tid & 63, wl = (tid >> 6) & 3;
    float* cwl = (float*)smem;
    bf16_t* Kn = (bf16_t*)(smem + 4096 + hb * 17408);
    const int unit = unit0 + hb;
    const int c = unit & 127, hd = (unit >> 7) & 7, b = unit >> 10;
    const size_t row0 = (size_t)b * SEQ_ + (size_t)c * 64;
    __syncthreads();
    for (int i = tid; i < 1024; i += 512) { const int j = i >> 8, ch = i & 255; cwl[i] = p.mconv[(size_t)j * 2048 + (ch >> 7) * 1024 + hd * 128 + (ch & 127)]; }
    __syncthreads();
    u32x4 res[8];
#pragma unroll
    for (int r = 0; r < 8; ++r) {
        const int item = ht + 256 * r, chg = item & 15, t = (item >> 4) & 63, which = item >> 10;
        float y[8];
        conv_item(P1, HB, b, c, t, 8192 + which * 1024 + hd * 128 + chg * 8, cwl + which * 128 + chg * 8, 256, y);
        if (which == 0) {
#pragma unroll
            for (int e = 0; e < 8; ++e) y[e] *= 0.08838834764831845f;
        }
        res[r] = pack8(y);
        if (which == 1) *(u32x4*)(Kn + t * 136 + chg * 8) = res[r];
    }
    if (wl == 0) {
        const float ip = SM[(size_t)(64 + hd) * T_ + row0 + lane] + p.mbi[hd], fp = SM[(size_t)(72 + hd) * T_ + row0 + lane] + p.mbf[hd];
        const float lf = fminf(fp, 0.f) - log1pf(expf(-fabsf(fp)));
        const float bc = wave_scan_add(lf, lane);
        const float av = ip - bc;
        const float cm = wave_scan_max(av, lane);
        MS[(size_t)(b * 8 + hd) * SEQ_ + c * 64 + lane] = (f32x4){bc, av, cm, 0.f};
    }
    __syncthreads();
#pragma unroll
    for (int r = 0; r < 8; ++r) {
        const int item = ht + 256 * r, chg = item & 15, t = (item >> 4) & 63, which = item >> 10;
        *(u32x4*)(P1 + (row0 + t) * LDP + 8192 + which * 1024 + hd * 128 + chg * 8) = res[r];
    }
#pragma unroll
    for (int r = 0; r < 4; ++r) {
        const int pce = ht + 256 * r, dk = pce >> 3, t0 = (pce & 7) * 8;
        float f[8];
#pragma unroll
        for (int e = 0; e < 8; ++e) f[e] = bf2f(Kn[(t0 + e) * 136 + dk]);
        *(u32x4*)(KT + ((size_t)((b * 8 + hd) * 128 + c)) * 8192 + pce * 8) = pack8(f);
    }
}

__device__ void gdn_scan(const Params& p, unsigned char* smem, int unit) {
    bf16_t* P1 = (bf16_t*)(p.ws + OFF_P1); const bf16_t* WB = (const bf16_t*)(p.ws + OFF_WB); const float* GC = (const float*)(p.ws + OFF_GC);
    float* RSA = (float*)(p.ws + OFF_RSA);
    const bf16_t* AT = (const bf16_t*)p.out + (size_t)T_ * 2048;
    bf16_t* Wl = (bf16_t*)smem;
    bf16_t* Ql = Wl + 64 * 136;
    bf16_t* St = Ql + 64 * 136;
    bf16_t* Kt = St + 64 * 136;
    bf16_t* At = Kt + 128 * 72;
    bf16_t* Vt = At + 64 * 72;
    bf16_t* V2 = Vt + 64 * 72;
    bf16_t* Ul = V2 + 64 * 72;
    bf16_t* Ol = Ul + 64 * 72;
    float* gcl = (float*)(Ol + 64 * 72);
    int tid_ = threadIdx.x; asm volatile("" : "+v"(tid_));
    const int tid = tid_, lane = tid & 63, w = tid >> 6, l15 = lane & 15, quad = lane >> 4;
    const int bh = unit >> 1, b = bh >> 5, h = bh & 31, qkh = h >> 1, sl = unit & 1, dv0 = sl * 64;
    const size_t rowb = (size_t)b * SEQ_;
    u32x4 rw[2][2], rq[2][2], rk[2][2], ra[2], ru[2]; float rg[2];
#define GDN_ISSUE(S, cc) do { const size_t r0_ = rowb + (size_t)(cc) * 64; \
        _Pragma("unroll") for (int i_ = 0; i_ < 2; ++i_) { const int p_ = tid + 512 * i_, t_ = p_ >> 4, s_ = p_ & 15; \
            rw[S][i_] = *(const u32x4*)(WB + (r0_ + t_) * 4096 + h * 128 + s_ * 8); \
            rq[S][i_] = *(const u32x4*)(P1 + (r0_ + t_) * LDP + qkh * 128 + s_ * 8); \
            rk[S][i_] = *(const u32x4*)(P1 + (r0_ + t_) * LDP + 2048 + qkh * 128 + s_ * 8); } \
        ra[S] = *(const u32x4*)(AT + ((size_t)(b * 32 + h) * 128 + (cc)) * 4096 + tid * 8); \
        ru[S] = *(const u32x4*)(P1 + (r0_ + (tid >> 3)) * LDP + 4096 + h * 128 + dv0 + (tid & 7) * 8); \
        if (w == 0) rg[S] = GC[(size_t)(b * 32 + h) * SEQ_ + (cc) * 64 + lane]; } while (0)
#define GDN_STAGE1(S) do { \
        _Pragma("unroll") for (int i_ = 0; i_ < 2; ++i_) { const int p_ = tid + 512 * i_, t_ = p_ >> 4, s_ = p_ & 15; \
            *(u32x4*)(Wl + t_ * 136 + s_ * 8) = rw[S][i_]; *(u32x4*)(Ql + t_ * 136 + s_ * 8) = rq[S][i_]; } \
        *(u32x4*)(Ul + (tid >> 3) * 72 + (tid & 7) * 8) = ru[S]; \
        if (w == 0) gcl[lane] = rg[S]; } while (0)
#define GDN_STAGE2(S) do { \
        _Pragma("unroll") for (int i_ = 0; i_ < 2; ++i_) { const int p_ = tid + 512 * i_; \
            *(u32x4*)(Kt + (p_ >> 3) * 72 + (p_ & 7) * 8) = rk[S][i_]; } \
        *(u32x4*)(At + (tid >> 3) * 72 + (tid & 7) * 8) = ra[S]; } while (0)
    f32x4 Sacc[4];
#pragma unroll
    for (int n = 0; n < 4; ++n) Sacc[n] = (f32x4){0.f, 0.f, 0.f, 0.f};
    __syncthreads();
    for (int i = tid; i < 64 * 136 / 8; i += 512) *(u32x4*)(St + i * 8) = (u32x4){0u, 0u, 0u, 0u};
    GDN_ISSUE(0, 0); GDN_STAGE1(0); GDN_STAGE2(0);
    GDN_ISSUE(0, 1); GDN_ISSUE(1, 2);
    __syncthreads();
    const int tt = w >> 1, nb = (w & 1) * 2;
    for (int c2 = 0; c2 < 128; c2 += 2) {
#pragma unroll
      for (int par = 0; par < 2; ++par) {
        const int c = c2 + par;
        f32x4 ws[2], qs[2];
#pragma unroll
        for (int n = 0; n < 2; ++n) { ws[n] = (f32x4){0.f, 0.f, 0.f, 0.f}; qs[n] = (f32x4){0.f, 0.f, 0.f, 0.f}; }
        {
            bf16x8 aw[4], aq[4], bs[2][4];
#pragma unroll
            for (int kk = 0; kk < 4; ++kk) {
                aw[kk] = *(const bf16x8*)(Wl + (16 * tt + l15) * 136 + kk * 32 + quad * 8);
                bs[0][kk] = *(const bf16x8*)(St + (16 * nb + l15) * 136 + kk * 32 + quad * 8);
                bs[1][kk] = *(const bf16x8*)(St + (16 * (nb + 1) + l15) * 136 + kk * 32 + quad * 8);
                aq[kk] = *(const bf16x8*)(Ql + (16 * tt + l15) * 136 + kk * 32 + quad * 8);
            }
#pragma unroll
            for (int kk = 0; kk < 4; ++kk)
#pragma unroll
                for (int n = 0; n < 2; ++n) ws[n] = mfma16(aw[kk], bs[n][kk], ws[n]);
#pragma unroll
            for (int kk = 0; kk < 4; ++kk)
#pragma unroll
                for (int n = 0; n < 2; ++n) qs[n] = mfma16(aq[kk], bs[n][kk], qs[n]);
        }
        const float gl = gcl[63];
        float gr[4];
#pragma unroll
        for (int j = 0; j < 4; ++j) gr[j] = gcl[16 * tt + quad * 4 + j];
#pragma unroll
        for (int n = 0; n < 2; ++n) {
            const int dvc = 16 * (nb + n) + l15;
            float vn[4], v2[4];
#pragma unroll
            for (int j = 0; j < 4; ++j) {
                vn[j] = bf2f(Ul[(16 * tt + quad * 4 + j) * 72 + dvc]) - ws[n][j];
                v2[j] = vn[j] * __expf(gl - gr[j]);
                qs[n][j] *= __expf(gr[j]);
            }
            *(u32x2*)(Vt + dvc * 72 + 16 * tt + quad * 4) = pack4(vn[0], vn[1], vn[2], vn[3]);
            *(u32x2*)(V2 + dvc * 72 + 16 * tt + quad * 4) = pack4(v2[0], v2[1], v2[2], v2[3]);
        }
        __syncthreads();
        bf16x8 ak2[2], bv2[4][2];
        {
            bf16x8 aa[2], bv[2][2];
#pragma unroll
            for (int kk = 0; kk < 2; ++kk) {
                aa[kk] = *(const bf16x8*)(At + (16 * tt + l15) * 72 + kk * 32 + quad * 8);
                bv[0][kk] = *(const bf16x8*)(Vt + (16 * nb + l15) * 72 + kk * 32 + quad * 8);
                bv[1][kk] = *(const bf16x8*)(Vt + (16 * (nb + 1) + l15) * 72 + kk * 32 + quad * 8);
            }
#pragma unroll
            for (int kk = 0; kk < 2; ++kk) {
                ak2[kk] = *(const bf16x8*)(Kt + (16 * w + l15) * 72 + kk * 32 + quad * 8);
#pragma unroll
                for (int n = 0; n < 4; ++n) bv2[n][kk] = *(const bf16x8*)(V2 + (16 * n + l15) * 72 + kk * 32 + quad * 8);
            }
#pragma unroll
            for (int kk = 0; kk < 2; ++kk)
#pragma unroll
                for (int n = 0; n < 2; ++n) qs[n] = mfma16(aa[kk], bv[n][kk], qs[n]);
        }
#pragma unroll
        for (int n = 0; n < 2; ++n)
#pragma unroll
            for (int j = 0; j < 4; ++j) Ol[(16 * tt + quad * 4 + j) * 72 + 16 * (nb + n) + l15] = f2bf(qs[n][j]);
        const float gt = __expf(gl);
#pragma unroll
        for (int n = 0; n < 4; ++n) Sacc[n] *= gt;
#pragma unroll
        for (int kk = 0; kk < 2; ++kk)
#pragma unroll
            for (int n = 0; n < 4; ++n) Sacc[n] = mfma16(ak2[kk], bv2[n][kk], Sacc[n]);
#pragma unroll
        for (int n = 0; n < 4; ++n) *(u32x2*)(St + (16 * n + l15) * 136 + 16 * w + quad * 4) = pack4(Sacc[n][0], Sacc[n][1], Sacc[n][2], Sacc[n][3]);
        if (c + 1 < 128) { if (par == 0) GDN_STAGE1(0); else GDN_STAGE1(1); }
        __syncthreads();
        {
            const int t = tid >> 3, seg = tid & 7;
            const u32x4 o = *(const u32x4*)(Ol + t * 72 + seg * 8);
            const size_t row = rowb + (size_t)c * 64 + t;
            *(u32x4*)(P1 + row * LDP + 4096 + h * 128 + dv0 + seg * 8) = o;
            float f[8]; unpack8(o, f);
            float ss = 0.f;
#pragma unroll
            for (int e = 0; e < 8; ++e) ss += f[e] * f[e];
            ss += __shfl_xor(ss, 1); ss += __shfl_xor(ss, 2); ss += __shfl_xor(ss, 4);
            if (seg == 0) RSA[(size_t)((b * 32 + h) * 2 + sl) * SEQ_ + c * 64 + t] = ss;
        }
        if (par == 0) { if (c + 1 < 128) GDN_STAGE2(0); if (c + 3 < 128) GDN_ISSUE(0, c + 3); }
        else          { if (c + 1 < 128) GDN_STAGE2(1); if (c + 3 < 128) GDN_ISSUE(1, c + 3); }
      }
    }
#undef GDN_ISSUE
#undef GDN_STAGE1
#undef GDN_STAGE2
}

__device__ void mlstm_scan(const Params& p, unsigned char* smem, int unit) {
    bf16_t* P1 = (bf16_t*)(p.ws + OFF_P1); float* RSB = (float*)(p.ws + OFF_RSB);
    const bf16_t* KT = (const bf16_t*)(p.ws + OFF_WT1); const f32x4* MS = (const f32x4*)(p.ws + OFF_WT1 + 33554432);
    bf16_t* Qc = (bf16_t*)smem;
    bf16_t* Kc = Qc + 64 * 136;
    bf16_t* Ct = Kc + 64 * 136;
    bf16_t* Kt = Ct + 48 * 136;
    bf16_t* Sl = Kt + 128 * 72;
    bf16_t* Vx = Sl + 64 * 72;
    bf16_t* V2 = Vx + 48 * 72;
    bf16_t* Ol = V2 + 48 * 72;
    float* aL = (float*)(Ol + 64 * 40);
    float* ML = aL + 64; float* wiL = ML + 64; float* enL = wiL + 64;
    int tid_ = threadIdx.x; asm volatile("" : "+v"(tid_));
    const int tid = tid_, lane = tid & 63, w = tid >> 6, l15 = lane & 15, quad = lane >> 4;
    const int bh = unit >> 3, b = bh >> 3, hd = bh & 7, sl = unit & 7, dv0 = sl * 32;
    const size_t rowb = (size_t)b * SEQ_;
    u32x4 rq[2][2], rk[2][2], rkt[2][2], rv[2]; f32x4 rms[2];
    float m_state = 0.f, cd = 1.f;
#define ML_ISSUE(S, cc) do { const size_t r0_ = rowb + (size_t)(cc) * 64; \
        _Pragma("unroll") for (int i_ = 0; i_ < 2; ++i_) { const int p_ = tid + 512 * i_, t_ = p_ >> 4, s_ = p_ & 15; \
            rq[S][i_] = *(const u32x4*)(P1 + (r0_ + t_) * LDP + 8192 + hd * 128 + s_ * 8); \
            rk[S][i_] = *(const u32x4*)(P1 + (r0_ + t_) * LDP + 9216 + hd * 128 + s_ * 8); \
            rkt[S][i_] = *(const u32x4*)(KT + ((size_t)((b * 8 + hd) * 128 + (cc))) * 8192 + p_ * 8); } \
        if (tid < 256) rv[S] = *(const u32x4*)(P1 + (r0_ + (tid >> 2)) * LDP + 10240 + hd * 256 + dv0 + (tid & 3) * 8); \
        rms[S] = MS[(size_t)(b * 8 + hd) * SEQ_ + (cc) * 64 + lane]; } while (0)
    float wk_s = 0.f, wi_s = 0.f, en_s = 0.f;
#define ML_STAGE1(S) do { \
        const float bc_ = rms[S].x, a_ = rms[S].y, cm_ = rms[S].z; \
        const float M_ = fmaxf(m_state, cm_); \
        const float M63_ = __shfl(M_, 63), bl_ = __shfl(bc_, 63); \
        wk_s = __expf(a_ - M63_); wi_s = __expf(m_state - M_); en_s = __expf(-(bc_ + M_)); \
        if (w == 0) { aL[lane] = a_; ML[lane] = M_; } \
        cd = __expf(m_state - M63_); m_state = bl_ + M63_; \
        _Pragma("unroll") for (int i_ = 0; i_ < 2; ++i_) { const int p_ = tid + 512 * i_, t_ = p_ >> 4, s_ = p_ & 15; \
            *(u32x4*)(Qc + t_ * 136 + s_ * 8) = rq[S][i_]; *(u32x4*)(Kc + t_ * 136 + s_ * 8) = rk[S][i_]; } } while (0)
#define ML_STAGE2(S) do { \
        if (w == 0) { wiL[lane] = wi_s; enL[lane] = en_s; } \
        _Pragma("unroll") for (int i_ = 0; i_ < 2; ++i_) { const int p_ = tid + 512 * i_; \
            *(u32x4*)(Kt + (p_ >> 3) * 72 + (p_ & 7) * 8) = rkt[S][i_]; } \
        if (tid < 256) { const int t_ = tid >> 2, d0_ = (tid & 3) * 8; const float wkt_ = __shfl(wk_s, t_); \
            _Pragma("unroll") for (int e_ = 0; e_ < 8; ++e_) { const int ee_ = (e_ + 2 * (tid & 3)) & 7; \
                const unsigned w01_ = (ee_ & 2) ? rv[S].y : rv[S].x, w23_ = (ee_ & 2) ? rv[S].w : rv[S].z, ws_ = (ee_ & 4) ? w23_ : w01_; \
                const unsigned hv_ = (ee_ & 1) ? (ws_ >> 16) : (ws_ & 0xffffu); \
                Vx[(d0_ + ee_) * 72 + t_] = (bf16_t)hv_; V2[(d0_ + ee_) * 72 + t_] = f2bf(__uint_as_float(hv_ << 16) * wkt_); } } \
        if (w == 4) { Vx[32 * 72 + lane] = (bf16_t)0x3f80u; V2[32 * 72 + lane] = f2bf(wk_s); } } while (0)
    f32x4 Cacc[3];
#pragma unroll
    for (int n = 0; n < 3; ++n) Cacc[n] = (f32x4){0.f, 0.f, 0.f, 0.f};
    __syncthreads();
    for (int i = tid; i < 48 * 136 / 8; i += 512) *(u32x4*)(Ct + i * 8) = (u32x4){0u, 0u, 0u, 0u};
    for (int i = tid; i < 2 * 48 * 72 / 8; i += 512) *(u32x4*)(Vx + i * 8) = (u32x4){0u, 0u, 0u, 0u};
    __syncthreads();
    ML_ISSUE(0, 0); ML_STAGE1(0); ML_STAGE2(0);
    ML_ISSUE(0, 1); ML_ISSUE(1, 2);
    __syncthreads();
    const int tt = w >> 1, half = w & 1;
    for (int c2 = 0; c2 < 128; c2 += 2) {
#pragma unroll
      for (int par = 0; par < 2; ++par) {
        const int c = c2 + par;
        const float cd_cur = cd;
#pragma unroll
        for (int e = 0; e < 2; ++e) {
            const int idx = 2 * w + e, tj = idx >> 2, ti = idx & 3;
            f32x4 a = (f32x4){0.f, 0.f, 0.f, 0.f};
            if (tj <= ti) {
                bf16x8 ak[4], bq[4];
#pragma unroll
                for (int kk = 0; kk < 4; ++kk) {
                    ak[kk] = *(const bf16x8*)(Kc + (16 * tj + l15) * 136 + kk * 32 + quad * 8);
                    bq[kk] = *(const bf16x8*)(Qc + (16 * ti + l15) * 136 + kk * 32 + quad * 8);
                }
#pragma unroll
                for (int kk = 0; kk < 4; ++kk) a = mfma16(ak[kk], bq[kk], a);
            }
            const int ig = 16 * ti + l15;
            const float Mi = ML[ig];
            float sv[4];
#pragma unroll
            for (int j = 0; j < 4; ++j) { const int jg = 16 * tj + quad * 4 + j; sv[j] = (jg <= ig) ? a[j] * __expf(fminf(aL[jg] - Mi, 0.f)) : 0.f; }
            *(u32x2*)(Sl + ig * 72 + 16 * tj + quad * 4) = pack4(sv[0], sv[1], sv[2], sv[3]);
        }
        f32x4 qc[2];
        qc[0] = (f32x4){0.f, 0.f, 0.f, 0.f}; qc[1] = (f32x4){0.f, 0.f, 0.f, 0.f};
        {
            bf16x8 aq[4], b0[4], b1[4];
#pragma unroll
            for (int kk = 0; kk < 4; ++kk) {
                aq[kk] = *(const bf16x8*)(Qc + (16 * tt + l15) * 136 + kk * 32 + quad * 8);
                b0[kk] = *(const bf16x8*)(Ct + (16 * half + l15) * 136 + kk * 32 + quad * 8);
                b1[kk] = *(const bf16x8*)(Ct + (32 + l15) * 136 + kk * 32 + quad * 8);
            }
#pragma unroll
            for (int kk = 0; kk < 4; ++kk) { qc[0] = mfma16(aq[kk], b0[kk], qc[0]); qc[1] = mfma16(aq[kk], b1[kk], qc[1]); }
        }
        __syncthreads();
        bf16x8 ak3[2], bv3[3][2];
        {
            float wi[4], en[4];
#pragma unroll
            for (int j = 0; j < 4; ++j) { wi[j] = wiL[16 * tt + quad * 4 + j]; en[j] = enL[16 * tt + quad * 4 + j]; qc[0][j] *= wi[j]; qc[1][j] *= wi[j]; }
            {
                bf16x8 as[2], b0[2], b1[2];
#pragma unroll
                for (int kk = 0; kk < 2; ++kk) {
                    as[kk] = *(const bf16x8*)(Sl + (16 * tt + l15) * 72 + kk * 32 + quad * 8);
                    b0[kk] = *(const bf16x8*)(Vx + (16 * half + l15) * 72 + kk * 32 + quad * 8);
                    b1[kk] = *(const bf16x8*)(Vx + (32 + l15) * 72 + kk * 32 + quad * 8);
                }
#pragma unroll
                for (int kk = 0; kk < 2; ++kk) {
                    ak3[kk] = *(const bf16x8*)(Kt + (16 * w + l15) * 72 + kk * 32 + quad * 8);
#pragma unroll
                    for (int n = 0; n < 3; ++n) bv3[n][kk] = *(const bf16x8*)(V2 + (16 * n + l15) * 72 + kk * 32 + quad * 8);
                }
#pragma unroll
                for (int kk = 0; kk < 2; ++kk) { qc[0] = mfma16(as[kk], b0[kk], qc[0]); qc[1] = mfma16(as[kk], b1[kk], qc[1]); }
            }
#pragma unroll
            for (int j = 0; j < 4; ++j) {
                const float den = __shfl(qc[1][j], quad * 16);
                const float hv = qc[0][j] * __builtin_amdgcn_rcpf(fmaxf(fabsf(den), en[j]));
                Ol[(16 * tt + quad * 4 + j) * 40 + 16 * half + l15] = f2bf(hv);
            }
        }
#pragma unroll
        for (int n = 0; n < 3; ++n) Cacc[n] *= cd_cur;
#pragma unroll
        for (int kk = 0; kk < 2; ++kk)
#pragma unroll
            for (int n = 0; n < 3; ++n) Cacc[n] = mfma16(ak3[kk], bv3[n][kk], Cacc[n]);
#pragma unroll
        for (int n = 0; n < 3; ++n) *(u32x2*)(Ct + (16 * n + l15) * 136 + 16 * w + quad * 4) = pack4(Cacc[n][0], Cacc[n][1], Cacc[n][2], Cacc[n][3]);
        if (c + 1 < 128) { if (par == 0) ML_STAGE1(0); else ML_STAGE1(1); }
        __syncthreads();
        if (tid < 256) {
            const int t = tid >> 2, seg = tid & 3;
            const u32x4 o = *(const u32x4*)(Ol + t * 40 + seg * 8);
            const size_t row = rowb + (size_t)c * 64 + t;
            *(u32x4*)(P1 + row * LDP + 10240 + hd * 256 + dv0 + seg * 8) = o;
            float f[8]; unpack8(o, f);
            float ss = 0.f;
#pragma unroll
            for (int e = 0; e < 8; ++e) ss += f[e] * f[e];
            ss += __shfl_xor(ss, 1); ss += __shfl_xor(ss, 2);
            if (seg == 0) RSB[(size_t)((b * 8 + hd) * 8 + sl) * SEQ_ + c * 64 + t] = ss;
        }
        if (par == 0) { if (c + 1 < 128) ML_STAGE2(0); if (c + 3 < 128) ML_ISSUE(0, c + 3); }
        else          { if (c + 1 < 128) ML_STAGE2(1); if (c + 3 < 128) ML_ISSUE(1, c + 3); }
      }
    }
#undef ML_ISSUE
#undef ML_STAGE1
#undef ML_STAGE2
}

__device__ void phase_final(const Params& p, unsigned char* smem) {
    float* gl = (float*)smem;
    const float* MODP = (const float*)(p.ws + OFF_MODP);
    const float* OUTF = (const float*)(p.ws + OFF_WB); const float* SSQ = (const float*)(p.ws + OFF_SSQ);
    int tid_ = threadIdx.x; asm volatile("" : "+v"(tid_));
    const int tid = tid_, lane = tid & 63, w = tid >> 6;
    for (int blk = blockIdx.x; blk < T_ / 64; blk += gridDim.x) {
        const int b = (blk * 64) >> 13;
        __syncthreads();
        for (int col = tid; col < 2048; col += 512) {
            float s0 = p.b_ada[4096 + col];
#pragma unroll
            for (int ks = 0; ks < 8; ++ks) s0 += MODP[(ks * 2 + b) * 6144 + 4096 + col];
            gl[col] = s0;
        }
        __syncthreads();
#pragma unroll 2
        for (int i = 0; i < 8; ++i) {
            const int row = blk * 64 + w * 8 + i;
            float ss = (lane < 32) ? SSQ[(size_t)row * 32 + lane] : 0.f;
            ss = wave_sum(ss);
            const float rstd = rsqrtf(ss * (1.0f / 2048.0f) + EPS);
#pragma unroll
            for (int e = 0; e < 8; ++e) {
                const int col = lane * 4 + 256 * e;
                const f32x4 xv = *(const f32x4*)(p.x + (size_t)row * 2048 + col);
                const u32x2 ow = *(const u32x2*)((const bf16_t*)OUTF + (size_t)row * 2048 + col);
                const f32x4 ov = (f32x4){bflo(ow.x), bfhi(ow.x), bflo(ow.y), bfhi(ow.y)};
                const f32x4 nw = *(const f32x4*)(p.npost + col), gv = *(const f32x4*)(gl + col);
                f32x4 r;
#pragma unroll
                for (int k = 0; k < 4; ++k) r[k] = xv[k] + gv[k] * (ov[k] * rstd * nw[k]);
                *(f32x4*)(p.out + (size_t)row * 2048 + col) = r;
            }
        }
    }
}


#define XB_TMO      128
#define XB_XCNT(j)  (256  + 64 * (j))
#define XB_XSUB(j)  (1280 + 64 * (j))
#define XB_XGEN(j)  (2304 + 64 * (j))
#define XB_TOP      3328
#define XB_TOPGEN   3392
#define XCD_BAR_WORDS 3456
#define XB_SPIN_CAP (1u << 21)
__device__ __forceinline__ unsigned xb_ld(unsigned* p)              { return __hip_atomic_load(p, __ATOMIC_RELAXED, __HIP_MEMORY_SCOPE_AGENT); }
__device__ __forceinline__ unsigned xb_add(unsigned* p, unsigned v) { return __hip_atomic_fetch_add(p, v, __ATOMIC_RELAXED, __HIP_MEMORY_SCOPE_AGENT); }
__device__ __forceinline__ unsigned xb_xcc_id() { return (unsigned)__builtin_amdgcn_s_getreg((3 << 11) | 20) & 0xFu; }
#define XB_SPIN(cond, bar) do { unsigned _sp = 0; while (cond) { __builtin_amdgcn_s_sleep(1); \
    if ((++_sp & 255u) == 0u) { if (xb_ld(&(bar)[XB_TMO])) break; if (_sp > XB_SPIN_CAP) { atomicAdd(&(bar)[XB_TMO], 1u); break; } } } } while (0)
__device__ __forceinline__ void xcd_barrier_complete(unsigned* bar, unsigned x, unsigned& nloc, unsigned& nx) {
    const unsigned G = gridDim.x * gridDim.y * gridDim.z;
    unsigned sum, cnt, mine, sp = 0u;
    for (;;) {
        sum = 0u; cnt = 0u; mine = 0u;
#pragma unroll
        for (unsigned j = 0; j < 16; ++j) { const unsigned c = xb_ld(&bar[XB_XCNT(j)]); sum += c; cnt += (c > 0u) ? 1u : 0u; mine = (j == x) ? c : mine; }
        if (sum == G) break;
        __builtin_amdgcn_s_sleep(1);
        if ((++sp & 255u) == 0u) { if (xb_ld(&bar[XB_TMO])) break; if (sp > XB_SPIN_CAP) { atomicAdd(&bar[XB_TMO], 1u); break; } }
    }
    nloc = mine > 0u ? mine : 1u; nx = cnt > 0u ? cnt : 1u;
}
__device__ __forceinline__ void xcd_barrier(unsigned* bar, volatile LAS unsigned* st) {
    asm volatile("s_waitcnt vmcnt(0)" ::: "memory");
    __syncthreads();
    if (threadIdx.x == 0) {
        const unsigned x = xb_xcc_id();
        __builtin_amdgcn_s_waitcnt(0);
        unsigned nloc = st[0], nx = st[1];
        if (nloc == 0u) { xcd_barrier_complete(bar, x, nloc, nx); st[0] = nloc; st[1] = nx; }
        const unsigned old = xb_add(&bar[XB_XSUB(x)], 1u);
        const unsigned gen = old / nloc;
        if (old + 1u == (gen + 1u) * nloc) {
            __builtin_amdgcn_fence(__ATOMIC_RELEASE, "agent");
            asm volatile("s_waitcnt vmcnt(0)" ::: "memory");
            const unsigned og = xb_add(&bar[XB_TOP], 1u);
            const unsigned tg = og / nx;
            if (og + 1u == (tg + 1u) * nx) xb_add(&bar[XB_TOPGEN], 1u);
            else XB_SPIN(xb_ld(&bar[XB_TOPGEN]) == tg, bar);
            __builtin_amdgcn_fence(__ATOMIC_ACQUIRE, "agent");
            xb_add(&bar[XB_XGEN(x)], 1u);
            asm volatile("s_waitcnt vmcnt(0)" ::: "memory");
        } else {
            XB_SPIN(xb_ld(&bar[XB_XGEN(x)]) == gen, bar);
            __builtin_amdgcn_fence(__ATOMIC_ACQUIRE, "agent");
            asm volatile("s_waitcnt vmcnt(0)" ::: "memory");
        }
    }
    __syncthreads();
}

template <int PH>
__global__ void __launch_bounds__(512) mk_kernel(Params p) {
    extern __shared__ __attribute__((aligned(16))) unsigned char smem[];
    LAS unsigned char* lds = (LAS unsigned char*)smem;
    pg8::StaticOrder so;
    unsigned* bar = (unsigned*)(p.ws + OFF_BAR);
    volatile LAS unsigned* st = (volatile LAS unsigned*)(lds + LDS_MAIN);
    if (PH < 0) {
        if (threadIdx.x == 0) { st[0] = 0u; st[1] = 0u; }
        if (blockIdx.x == 0) { for (int i = threadIdx.x; i < XCD_BAR_WORDS; i += 512) __hip_atomic_store(&bar[i], 0u, __ATOMIC_RELAXED, __HIP_MEMORY_SCOPE_AGENT); }
        __syncthreads();
    }
#define SYNC() do { if (PH < 0) xcd_barrier((unsigned*)(p.ws + OFF_BAR), (volatile LAS unsigned*)(lds + LDS_MAIN)); } while (0)
    if (PH < 0 || PH == 0) phase0(p, smem);
    if (PH < 0) cg::this_grid().sync();
    if (PH < 0) { if (threadIdx.x == 0) (void)xb_add(&bar[XB_XCNT(xb_xcc_id())], 1u); }
    if (PH < 0 || PH == 1) phase1(p, smem);
    SYNC();
    if (PH < 0 || PH == 2) {
        pg8::Gemm g{(const bf16_t*)p.out, (const bf16_t*)(p.ws + OFF_WT1), 2048, T_, N1, 2048};
        so.init(T_, N1, gridDim.x, blockIdx.x);
        Epi1 e{(bf16_t*)(p.ws + OFF_P1), (bf16_t*)(p.ws + OFF_HB), (float*)(p.ws + OFF_SM)};
        pg8::gemm_phase(lds, g, so, e);
        { const int nfull = (T_ / 256) * (N1 / 256) - 12 * (int)gridDim.x;
          const int first = (nfull > 0 && nfull < (int)gridDim.x) ? nfull : 0;
          if ((int)blockIdx.x >= first) late_transposes(p, smem, (int)blockIdx.x - first, (int)gridDim.x - first); }
    }
    SYNC();
    if (PH < 0 || PH == 3) {
        for (int u = blockIdx.x * 2; u < 4096; u += gridDim.x * 2) prep_gdn(p, smem, u);
        for (int u = blockIdx.x * 2; u < 2048; u += gridDim.x * 2) prep_mlstm(p, smem, u);
    }
    SYNC();
    if (PH < 0 || PH == 4) {
        for (int u = blockIdx.x; u < 256; u += gridDim.x) {
            if (u < 128) { const int xcd = u & 7, kk = u >> 3, qg = xcd * 4 + (kk >> 2), wi = kk & 3;
                           const int bh = (qg >> 4) * 32 + (qg & 15) * 2 + (wi >> 1);
                           gdn_scan(p, smem, (bh << 1) | (wi & 1)); }
            else         { const int m = u - 128, xcd = m & 7, kk = m >> 3, stream = xcd * 2 + (kk >> 3);
                           mlstm_scan(p, smem, (stream << 3) | (kk & 7)); }
        }
    }
    SYNC();
    if (PH < 0 || PH == 5) {
        pg8::Gemm g{(const bf16_t*)p.out, (const bf16_t*)(p.ws + OFF_WT2), 2048, T_, N2, 2048};
        so.init(T_, N2, gridDim.x, blockIdx.x);
        Epi2 e{(bf16_t*)(p.ws + OFF_P1), (const float*)(p.ws + OFF_RSA), (const float*)(p.ws + OFF_RSB), p.gnw, p.mnw};
        pg8::gemm_phase(lds, g, so, e);
    }
    SYNC();
    if (PH < 0 || PH == 6) {
        so.init(T_, 2048, gridDim.x, blockIdx.x);
        { pg8::Gemm g{(const bf16_t*)(p.ws + OFF_P1) + 4096, (const bf16_t*)(p.ws + OFF_WTA), LDP, T_, 2048, 4096};
          EpiA e{(const bf16_t*)(p.ws + OFF_P1), p.out};
          pg8::gemm_phase(lds, g, so, e); }
        { pg8::Gemm g{(const bf16_t*)(p.ws + OFF_P1) + 10240, (const bf16_t*)(p.ws + OFF_WTB), LDP, T_, 2048, 2048};
          EpiB e{(bf16_t*)(p.ws + OFF_P1), p.out};
          pg8::gemm_phase(lds, g, so, e); }
    }
    SYNC();
    if (PH < 0 || PH == 7) {
        so.init(T_, 2048, gridDim.x, blockIdx.x);
        pg8::Gemm g{(const bf16_t*)(p.ws + OFF_P1) + 8192, (const bf16_t*)(p.ws + OFF_WTO), LDP, T_, 2048, 2048};
        EpiO e{(float*)(p.ws + OFF_WB), (float*)(p.ws + OFF_SSQ)};
        pg8::gemm_phase(lds, g, so, e);
    }
    SYNC();
    if (PH < 0 || PH == 8) phase_final(p, smem);
#undef SYNC
}

#ifndef MK_MULTI
#define MK_MULTI 0
#endif

template <int PH> static void launch_one(const Params& p, hipStream_t stream) {
    hipFuncSetAttribute((const void*)mk_kernel<PH>, hipFuncAttributeMaxDynamicSharedMemorySize, LDS_BYTES);
    hipLaunchKernelGGL(mk_kernel<PH>, dim3(256), dim3(512), LDS_BYTES, stream, p);
}

extern "C" void kernel_launch(void* const* d_in, const int* in_sizes, int n_in, void* d_out, int out_size, void* d_ws, size_t ws_size, hipStream_t stream) {
    Params p{};
    p.x = (const float*)d_in[0]; p.c = (const float*)d_in[1]; p.w_ada = (const float*)d_in[2]; p.b_ada = (const float*)d_in[3];
    p.npre = (const float*)d_in[4]; p.w_in = (const float*)d_in[5]; p.gconv = (const float*)d_in[6]; p.Alog = (const float*)d_in[7];
    p.dtb = (const float*)d_in[8]; p.gnw = (const float*)d_in[9]; p.mconv = (const float*)d_in[10]; p.mbi = (const float*)d_in[11];
    p.mbf = (const float*)d_in[12]; p.mnw = (const float*)d_in[13]; p.wpa = (const float*)d_in[14]; p.wpb = (const float*)d_in[15];
    p.wout = (const float*)d_in[16]; p.npost = (const float*)d_in[17];
    p.out = (float*)d_out; p.ws = (unsigned char*)d_ws;
    if (ws_size < WS_NEED) { fprintf(stderr, "workspace too small: %zu < %zu\n", ws_size, (size_t)WS_NEED); return; }
#if MK_MULTI
    launch_one<0>(p, stream); launch_one<1>(p, stream); launch_one<2>(p, stream); launch_one<3>(p, stream); launch_one<4>(p, stream);
    launch_one<5>(p, stream); launch_one<6>(p, stream); launch_one<7>(p, stream); launch_one<8>(p, stream);
#else
    static int grid_blocks = 0;
    if (!grid_blocks) {
        int dev = 0, cus = 0, per_cu = 0;
        hipGetDevice(&dev);
        hipDeviceGetAttribute(&cus, hipDeviceAttributeMultiprocessorCount, dev);
        hipFuncSetAttribute((const void*)mk_kernel<-1>, hipFuncAttributeMaxDynamicSharedMemorySize, LDS_BYTES);
        hipOccupancyMaxActiveBlocksPerMultiprocessor(&per_cu, mk_kernel<-1>, 512, LDS_BYTES);
        grid_blocks = cus * per_cu;
        if (grid_blocks > 256) grid_blocks = 256;
    }
    void* args[] = {&p};
    hipError_t e = hipLaunchCooperativeKernel((void*)mk_kernel<-1>, dim3(grid_blocks), dim3(512), args, LDS_BYTES, stream);
    if (e != hipSuccess) fprintf(stderr, "cooperative launch failed: %s (grid %d)\n", hipGetErrorString(e), grid_blocks);
#endif
}
```

```cpp
#include <hip/hip_runtime.h>
#include <hip/hip_cooperative_groups.h>
#include <cstdio>
namespace cg = cooperative_groups;

#define LAS __attribute__((address_space(3)))
typedef unsigned short bf16_t;
typedef short bf16x8 __attribute__((ext_vector_type(8)));
typedef float f32x4 __attribute__((ext_vector_type(4)));
typedef float f32x2 __attribute__((ext_vector_type(2)));
typedef unsigned u32x4 __attribute__((ext_vector_type(4)));
typedef unsigned u32x2 __attribute__((ext_vector_type(2)));

constexpr int T_ = 16384, SEQ_ = 8192;
constexpr int LDP = 12288;
constexpr int N1 = 12544, N2 = 12288, INW = 24656;
constexpr int LDS_MAIN = 142336;
constexpr int LDS_BYTES = LDS_MAIN + 256;
constexpr float EPS = 1e-6f;

constexpr size_t OFF_WT1 = 0;
constexpr size_t OFF_WT2 = OFF_WT1 + (size_t)N1 * 2048 * 2;
constexpr size_t OFF_WTA = OFF_WT2 + (size_t)N2 * 2048 * 2;
constexpr size_t OFF_WTB = OFF_WTA + (size_t)2048 * 4096 * 2;
constexpr size_t OFF_WTO = OFF_WTB + (size_t)2048 * 2048 * 2;
constexpr size_t OFF_P1 = OFF_WTO + (size_t)2048 * 2048 * 2;
constexpr size_t OFF_SM = OFF_P1 + (size_t)T_ * LDP * 2;
constexpr size_t OFF_HB = OFF_SM + (size_t)T_ * 80 * 4;
constexpr size_t OFF_WB = OFF_HB + (size_t)2 * 128 * 3 * 10240 * 2;
constexpr size_t OFF_GC = OFF_WB + (size_t)T_ * 4096 * 2;
constexpr size_t OFF_MODP = OFF_GC + (size_t)T_ * 32 * 4;
constexpr size_t OFF_RSA = OFF_MODP + (size_t)8 * 2 * 6144 * 4;
constexpr size_t OFF_RSB = OFF_RSA + (size_t)T_ * 32 * 2 * 4;
constexpr size_t OFF_SSQ = OFF_RSB + (size_t)T_ * 8 * 8 * 4;
constexpr size_t OFF_BAR = OFF_SSQ + (size_t)T_ * 32 * 4;
constexpr size_t WS_NEED = OFF_BAR + 16384;

struct Params {
    const float *x, *c, *w_ada, *b_ada, *npre, *w_in, *gconv, *Alog, *dtb, *gnw, *mconv, *mbi, *mbf, *mnw, *wpa, *wpb, *wout, *npost;
    float* out;
    unsigned char* ws;
};

typedef __bf16 bf16v2_t __attribute__((ext_vector_type(2)));
__device__ __forceinline__ unsigned cvt_pk_bf16(float lo, float hi) { bf16v2_t v; v.x = (__bf16)lo; v.y = (__bf16)hi; return __builtin_bit_cast(unsigned, v); }
__device__ __forceinline__ bf16_t f2bf(float f) { return (bf16_t)(cvt_pk_bf16(f, 0.f) & 0xffffu); }
__device__ __forceinline__ float bf2f(bf16_t v) { return __uint_as_float(((unsigned)v) << 16); }
__device__ __forceinline__ float bflo(unsigned w) { return __uint_as_float(w << 16); }
__device__ __forceinline__ float bfhi(unsigned w) { return __uint_as_float(w & 0xffff0000u); }
__device__ __forceinline__ float sigmoidf_(float x) { return __builtin_amdgcn_rcpf(1.0f + __expf(-x)); }
__device__ __forceinline__ float siluf_(float x) { return x * __builtin_amdgcn_rcpf(1.0f + __expf(-x)); }
__device__ __forceinline__ f32x4 mfma16(bf16x8 a, bf16x8 b, f32x4 c) { return __builtin_amdgcn_mfma_f32_16x16x32_bf16(a, b, c, 0, 0, 0); }
__device__ __forceinline__ void unpack8(const u32x4 v, float (&f)[8]) {
    f[0] = bflo(v.x); f[1] = bfhi(v.x); f[2] = bflo(v.y); f[3] = bfhi(v.y); f[4] = bflo(v.z); f[5] = bfhi(v.z); f[6] = bflo(v.w); f[7] = bfhi(v.w);
}
__device__ __forceinline__ u32x4 pack8(const float (&f)[8]) {
    u32x4 w; w.x = cvt_pk_bf16(f[0], f[1]); w.y = cvt_pk_bf16(f[2], f[3]); w.z = cvt_pk_bf16(f[4], f[5]); w.w = cvt_pk_bf16(f[6], f[7]); return w;
}
__device__ __forceinline__ u32x2 pack4(float a, float b, float c, float d) { u32x2 w; w.x = cvt_pk_bf16(a, b); w.y = cvt_pk_bf16(c, d); return w; }
__device__ __forceinline__ float wave_scan_add(float v, int lane) {
#pragma unroll
    for (int d = 1; d < 64; d <<= 1) { float t = __shfl_up(v, d); if (lane >= d) v += t; }
    return v;
}
__device__ __forceinline__ float wave_scan_max(float v, int lane) {
#pragma unroll
    for (int d = 1; d < 64; d <<= 1) { float t = __shfl_up(v, d); if (lane >= d) v = fmaxf(v, t); }
    return v;
}
__device__ __forceinline__ float wave_sum(float v) {
#pragma unroll
    for (int d = 32; d >= 1; d >>= 1) v += __shfl_xor(v, d);
    return v;
}

namespace pg8 {
constexpr int BM = 256, BK = 64, HALF = 128, HTB = HALF * BK * 2, STAGE_BYTES = 8 * HTB, NXCD = 8, WGM = 4;
__host__ __device__ __forceinline__ int lds_byte(int r, int c) { const int st = (r >> 4) * 2 + (c >> 5), rr = r & 15, cc = c & 31, ob = rr * 64 + cc * 2; return st * 1024 + (ob ^ (((ob >> 9) & 1) << 5)); }
__host__ __device__ __forceinline__ void stage_rc(int b, int& R, int& C) { const int st = b / 1024, sb = b % 1024, swz = sb ^ (((sb >> 9) & 1) << 5); R = (st >> 1) * 16 + swz / 64; C = (st & 1) * 32 + (swz % 64) / 2; }
__host__ __device__ __forceinline__ int perm32(int rho) { const int n = rho >> 4, i = rho & 15; return 8 * (i >> 2) + 4 * n + (i & 3); }
struct Unit { int pm, pn; };
struct Gemm { const bf16_t* A; const bf16_t* Bt; int lda; int M, N, K; };
struct StaticOrder {
    int nM, nN, nwg, G, c;
    __device__ void init(int M, int N, int G_, int c_) { nM = M / BM; nN = N / BM; nwg = nM * nN; G = G_; c = c_; }
    __device__ bool next(int i, Unit& u) const {
        const long L = (long)i * G + c; if (L >= nwg) return false;
        int wgid = (int)L; { const int q = nwg / NXCD, r = nwg % NXCD, xcd = wgid % NXCD, off = wgid / NXCD; wgid = (xcd < r ? xcd * (q + 1) : r * (q + 1) + (xcd - r) * q) + off; }
        const int nig = WGM * nN, gid = wgid / nig, fm = gid * WGM, gsz = (nM - fm) < WGM ? (nM - fm) : WGM;
        u.pm = fm + ((wgid % nig) % gsz); u.pn = (wgid % nig) / gsz; return true;
    }
};
template <class Epi>
__device__ __forceinline__ void gemm_phase(LAS unsigned char* lds, const Gemm g, const StaticOrder& S, const Epi& E) {
    int tid_ = threadIdx.x; asm volatile("" : "+v"(tid_));
    const int tid = tid_, wid = __builtin_amdgcn_readfirstlane(tid >> 6), lane = tid & 63, wr = wid >> 2, wc = wid & 3, fr = lane & 15, fq = lane >> 4;
    const int K = g.K, nt = K / BK;
    unsigned voffA[2], voffB[2];
#pragma unroll
    for (int i = 0; i < 2; ++i) { int R, C; stage_rc(tid * 16 + i * 8192, R, C); const int Rb = (R & ~31) + perm32(R & 31);
        voffA[i] = (unsigned)(R * g.lda + C) * 2u; voffB[i] = (unsigned)(Rb * K + C) * 2u; }
    const size_t kstep = (size_t)(BK * 2);
    const size_t hstepA = (size_t)HALF * g.lda * 2, tstepA = 2 * hstepA;
    const size_t hstepB = (size_t)HALF * K * 2, tstepB = 2 * hstepB;
    const unsigned ldsw = (unsigned)wid * 1024u;
    const int aoff = lds_byte(wr * 64 + fr, fq * 8), boff = lds_byte(wc * 32 + fr, fq * 8);
#define PG8_SA(b, h) (((b) * 2 + (h)) * HTB)
#define PG8_SB(b, h) ((4 + (b) * 2 + (h)) * HTB)
#define PG8_STAGE(bufoff, gbase, voff) do { _Pragma("unroll") for (int _i = 0; _i < 2; ++_i) \
        __builtin_amdgcn_global_load_lds((const unsigned*)((const char*)(gbase) + (voff)[_i]), (LAS unsigned*)(lds + (bufoff) + ldsw + _i * 8192), 16, 0, 0); } while (0)
#define PG8_LDA(dst, b, h) do { _Pragma("unroll") for (int m = 0; m < 4; ++m) _Pragma("unroll") for (int k = 0; k < 2; ++k) dst[m][k] = *(const LAS bf16x8*)(lds + PG8_SA(b, h) + aoff + m * 2048 + k * 1024); } while (0)
#define PG8_LDB(dst, b, h) do { _Pragma("unroll") for (int n = 0; n < 2; ++n) _Pragma("unroll") for (int k = 0; k < 2; ++k) dst[n][k] = *(const LAS bf16x8*)(lds + PG8_SB(b, h) + boff + n * 2048 + k * 1024); } while (0)
#define PG8_MMA(ai, bj, At, Bt) do { __builtin_amdgcn_s_setprio(1); _Pragma("unroll") for (int m = 0; m < 4; ++m) _Pragma("unroll") for (int n = 0; n < 2; ++n) _Pragma("unroll") for (int k = 0; k < 2; ++k) \
        acc[ai][bj][m][n] = __builtin_amdgcn_mfma_f32_16x16x32_bf16(Bt[n][k], At[m][k], acc[ai][bj][m][n], 0, 0, 0); __builtin_amdgcn_s_setprio(0); } while (0)
#define PG8_WAIT_V(n) asm volatile("s_waitcnt vmcnt(" #n ")" ::: "memory")
#define PG8_WAIT_L(n) asm volatile("s_waitcnt lgkmcnt(" #n ")" ::: "memory")
#define PG8_BAR __builtin_amdgcn_s_barrier()
#define PG8_SCHED __builtin_amdgcn_sched_barrier(0)
    Unit cur, nxt; int ui = 0;
    if (!S.next(0, cur)) return;
    f32x4 acc[2][2][4][2];
#pragma unroll
    for (int a = 0; a < 2; ++a)
#pragma unroll
        for (int b = 0; b < 2; ++b)
#pragma unroll
            for (int m = 0; m < 4; ++m)
#pragma unroll
                for (int n = 0; n < 2; ++n) acc[a][b][m][n] = (f32x4){0.f, 0.f, 0.f, 0.f};
    bf16x8 At[4][2], B0[2][2], B1[2][2];
    const char* cA = (const char*)g.A + (size_t)cur.pm * tstepA; const char* cB = (const char*)g.Bt + (size_t)cur.pn * tstepB;
    PG8_STAGE(PG8_SB(0, 0), cB, voffB); PG8_STAGE(PG8_SA(0, 0), cA, voffA); PG8_STAGE(PG8_SB(0, 1), cB + hstepB, voffB); PG8_STAGE(PG8_SA(0, 1), cA + hstepA, voffA);
    if (wr == 1) PG8_BAR;
    PG8_WAIT_V(4); PG8_BAR;
    PG8_STAGE(PG8_SB(1, 0), cB + kstep, voffB); PG8_STAGE(PG8_SA(1, 0), cA + kstep, voffA); PG8_STAGE(PG8_SB(1, 1), cB + hstepB + kstep, voffB);
    PG8_WAIT_V(6); PG8_BAR;
    for (;;) {
        const bool has_next = S.next(ui + 1, nxt);
        const char* nA = has_next ? (const char*)g.A + (size_t)nxt.pm * tstepA : cA; const char* nB = has_next ? (const char*)g.Bt + (size_t)nxt.pn * tstepB : cB;
        for (int t = 0; t < nt; t += 2) {
            const bool last = (t == nt - 2);
            const char* a1 = cA + (size_t)(t + 1) * kstep;
            const char* a2 = last ? nA : cA + (size_t)(t + 2) * kstep; const char* b2 = last ? nB : cB + (size_t)(t + 2) * kstep;
            const char* a3 = a2 + kstep; const char* b3 = b2 + kstep;
            PG8_LDB(B0, 0, 0); PG8_SCHED; PG8_LDA(At, 0, 0); PG8_STAGE(PG8_SA(1, 1), a1 + hstepA, voffA);
            PG8_WAIT_L(8); PG8_BAR; PG8_WAIT_L(0); PG8_MMA(0, 0, At, B0); PG8_BAR; PG8_SCHED;
            PG8_LDB(B1, 0, 1); PG8_STAGE(PG8_SB(0, 0), b2, voffB);
            PG8_BAR; PG8_WAIT_L(0); PG8_MMA(0, 1, At, B1); PG8_BAR;
            PG8_LDA(At, 0, 1); PG8_STAGE(PG8_SA(0, 0), a2, voffA);
            PG8_BAR; PG8_WAIT_L(0); PG8_MMA(1, 0, At, B0); PG8_BAR; PG8_SCHED;
            PG8_STAGE(PG8_SB(0, 1), b2 + hstepB, voffB);
            PG8_WAIT_V(6); PG8_BAR; PG8_MMA(1, 1, At, B1); PG8_BAR;
            PG8_LDB(B0, 1, 0); PG8_SCHED; PG8_LDA(At, 1, 0); PG8_STAGE(PG8_SA(0, 1), a2 + hstepA, voffA);
            PG8_WAIT_L(8); PG8_BAR; PG8_WAIT_L(0); PG8_MMA(0, 0, At, B0); PG8_BAR; PG8_SCHED;
            PG8_LDB(B1, 1, 1); PG8_STAGE(PG8_SB(1, 0), b3, voffB);
            PG8_BAR; PG8_WAIT_L(0); PG8_MMA(0, 1, At, B1); PG8_BAR;
            PG8_LDA(At, 1, 1); PG8_STAGE(PG8_SA(1, 0), a3, voffA);
            PG8_BAR; PG8_WAIT_L(0); PG8_MMA(1, 0, At, B0); PG8_BAR; PG8_SCHED;
            PG8_STAGE(PG8_SB(1, 1), b3 + hstepB, voffB);
            PG8_WAIT_V(6); PG8_BAR; PG8_MMA(1, 1, At, B1); PG8_BAR;
        }
        E(acc, cur, wr, wc, fr, fq);
        if (!has_next) break;
#pragma unroll
        for (int a = 0; a < 2; ++a)
#pragma unroll
            for (int b = 0; b < 2; ++b)
#pragma unroll
                for (int m = 0; m < 4; ++m)
#pragma unroll
                    for (int n = 0; n < 2; ++n) acc[a][b][m][n] = (f32x4){0.f, 0.f, 0.f, 0.f};
        cur = nxt; cA = nA; cB = nB; ++ui;
    }
    PG8_WAIT_V(0);
    if (wr == 0) PG8_BAR;
    PG8_BAR;
#undef PG8_SA
#undef PG8_SB
#undef PG8_STAGE
#undef PG8_LDA
#undef PG8_LDB
#undef PG8_MMA
#undef PG8_WAIT_V
#undef PG8_WAIT_L
#undef PG8_BAR
#undef PG8_SCHED
}
}

typedef f32x4 AccT[2][2][4][2];

struct Epi1 {
    bf16_t* P1; bf16_t* HB; float* SM;
    __device__ __forceinline__ void operator()(const AccT& acc, const pg8::Unit& u, int wr, int wc, int fr, int fq) const {
        if (u.pn < 48) {
#pragma unroll
            for (int ai = 0; ai < 2; ++ai)
#pragma unroll
                for (int m = 0; m < 4; ++m) {
                    const int row = u.pm * 256 + ai * 128 + wr * 64 + m * 16 + fr;
#pragma unroll
                    for (int bj = 0; bj < 2; ++bj) {
                        const int col = u.pn * 256 + bj * 128 + wc * 32 + 8 * fq;
                        const f32x4 v0 = acc[ai][bj][m][0], v1 = acc[ai][bj][m][1];
                        u32x4 w; w.x = cvt_pk_bf16(v0[0], v0[1]); w.y = cvt_pk_bf16(v0[2], v0[3]); w.z = cvt_pk_bf16(v1[0], v1[1]); w.w = cvt_pk_bf16(v1[2], v1[3]);
                        *(u32x4*)(P1 + (size_t)row * LDP + col) = w;
                        if (m == 3 && fr >= 13 && u.pn < 40) {
                            const int b = row >> 13, ch = (row & 8191) >> 6;
                            *(u32x4*)(HB + ((size_t)(b * 128 + ch) * 3 + (fr - 13)) * 10240 + col) = w;
                        }
                    }
                }
        } else {
#pragma unroll
            for (int ai = 0; ai < 2; ++ai)
#pragma unroll
                for (int m = 0; m < 4; ++m) {
                    const int row = u.pm * 256 + ai * 128 + wr * 64 + m * 16 + fr;
#pragma unroll
                    for (int bj = 0; bj < 2; ++bj) {
                        const int lc = bj * 128 + wc * 32 + 8 * fq;
                        if (lc < 80) {
#pragma unroll
                            for (int e = 0; e < 4; ++e) { SM[(size_t)(lc + e) * T_ + row] = acc[ai][bj][m][0][e]; SM[(size_t)(lc + 4 + e) * T_ + row] = acc[ai][bj][m][1][e]; }
                        }
                    }
                }
        }
    }
};

struct Epi2 {
    bf16_t* P1; const float* RSA; const float* RSB; const float* gnw; const float* mnw;
    __device__ __forceinline__ void operator()(const AccT& acc, const pg8::Unit& u, int wr, int wc, int fr, int fq) const {
        if (u.pn < 16) {
            f32x4 nwv[2][2];
#pragma unroll
            for (int bj = 0; bj < 2; ++bj) { const int ch = (bj * 128 + wc * 32 + 8 * fq) & 127; nwv[bj][0] = *(const f32x4*)(gnw + ch); nwv[bj][1] = *(const f32x4*)(gnw + ch + 4); }
#pragma unroll
            for (int ai = 0; ai < 2; ++ai) {
                u32x4 ov[4][2]; f32x2 pp[4][2];
#pragma unroll
                for (int m = 0; m < 4; ++m)
#pragma unroll
                    for (int bj = 0; bj < 2; ++bj) {
                        const int row = u.pm * 256 + ai * 128 + wr * 64 + m * 16 + fr;
                        const int gc = u.pn * 256 + bj * 128 + wc * 32 + 8 * fq, head = gc >> 7;
                        ov[m][bj] = *(const u32x4*)(P1 + (size_t)row * LDP + 4096 + gc);
                        { const int bb_ = row >> 13, ts_ = row & 8191; pp[m][bj].x = RSA[(size_t)((bb_ * 32 + head) * 2) * SEQ_ + ts_]; pp[m][bj].y = RSA[(size_t)((bb_ * 32 + head) * 2 + 1) * SEQ_ + ts_]; }
                    }
#pragma unroll
                for (int m = 0; m < 4; ++m)
#pragma unroll
                    for (int bj = 0; bj < 2; ++bj) {
                        const int row = u.pm * 256 + ai * 128 + wr * 64 + m * 16 + fr;
                        const int gc = u.pn * 256 + bj * 128 + wc * 32 + 8 * fq;
                        const float rstd = rsqrtf((pp[m][bj].x + pp[m][bj].y) * (1.0f / 128.0f) + EPS);
                        float o[8]; unpack8(ov[m][bj], o);
                        const f32x4 z0 = acc[ai][bj][m][0], z1 = acc[ai][bj][m][1];
                        float r[8];
#pragma unroll
                        for (int e = 0; e < 4; ++e) { r[e] = o[e] * rstd * nwv[bj][0][e] * siluf_(z0[e]); r[4 + e] = o[4 + e] * rstd * nwv[bj][1][e] * siluf_(z1[e]); }
                        *(u32x4*)(P1 + (size_t)row * LDP + 4096 + gc) = pack8(r);
                    }
                asm volatile("" ::: "memory");
            }
        } else if (u.pn < 32) {
            const int q = u.pn - 16;
            const int cc = q * 128 + wc * 32 + 8 * fq, head = cc >> 8;
            const f32x4 nw0 = *(const f32x4*)(mnw + cc), nw1 = *(const f32x4*)(mnw + cc + 4);
#pragma unroll
            for (int ai = 0; ai < 2; ++ai) {
                u32x4 ov[4]; f32x4 p0[4], p1[4];
#pragma unroll
                for (int m = 0; m < 4; ++m) {
                    const int row = u.pm * 256 + ai * 128 + wr * 64 + m * 16 + fr;
                    ov[m] = *(const u32x4*)(P1 + (size_t)row * LDP + 10240 + cc);
                    { const int bb_ = row >> 13, ts_ = row & 8191; const float* rb_ = RSB + (size_t)((bb_ * 8 + head) * 8) * SEQ_ + ts_;
#pragma unroll
                      for (int k_ = 0; k_ < 4; ++k_) { p0[m][k_] = rb_[(size_t)k_ * SEQ_]; p1[m][k_] = rb_[(size_t)(4 + k_) * SEQ_]; } }
                }
#pragma unroll
                for (int m = 0; m < 4; ++m) {
                    const int row = u.pm * 256 + ai * 128 + wr * 64 + m * 16 + fr;
                    const float ss = (p0[m][0] + p0[m][1]) + (p0[m][2] + p0[m][3]) + (p1[m][0] + p1[m][1]) + (p1[m][2] + p1[m][3]);
                    const float rstd = rsqrtf(ss * (1.0f / 256.0f) + EPS);
                    float o[8]; unpack8(ov[m], o);
                    const f32x4 g0 = acc[ai][0][m][0], g1 = acc[ai][0][m][1], z0 = acc[ai][1][m][0], z1 = acc[ai][1][m][1];
                    float r[8];
#pragma unroll
                    for (int e = 0; e < 4; ++e) { r[e] = sigmoidf_(g0[e]) * o[e] * rstd * nw0[e] * siluf_(z0[e]); r[4 + e] = sigmoidf_(g1[e]) * o[4 + e] * rstd * nw1[e] * siluf_(z1[e]); }
                    *(u32x4*)(P1 + (size_t)row * LDP + 10240 + cc) = pack8(r);
                }
                asm volatile("" ::: "memory");
            }
        } else {
#pragma unroll
            for (int ai = 0; ai < 2; ++ai)
#pragma unroll
                for (int m = 0; m < 4; ++m) {
                    const int row = u.pm * 256 + ai * 128 + wr * 64 + m * 16 + fr;
#pragma unroll
                    for (int bj = 0; bj < 2; ++bj) {
                        const int col = (u.pn - 32) * 256 + bj * 128 + wc * 32 + 8 * fq;
                        const f32x4 v0 = acc[ai][bj][m][0], v1 = acc[ai][bj][m][1];
                        float r[8];
#pragma unroll
                        for (int e = 0; e < 4; ++e) { r[e] = sigmoidf_(v0[e]); r[4 + e] = sigmoidf_(v1[e]); }
                        *(u32x4*)(P1 + (size_t)row * LDP + col) = pack8(r);
                    }
                }
        }
    }
};

struct EpiA {
    const bf16_t* P1; float* tmp;
    __device__ __forceinline__ void operator()(const AccT& acc, const pg8::Unit& u, int wr, int wc, int fr, int fq) const {
#pragma unroll
        for (int ai = 0; ai < 2; ++ai) {
            u32x4 sv[4][2];
#pragma unroll
            for (int m = 0; m < 4; ++m)
#pragma unroll
                for (int bj = 0; bj < 2; ++bj) {
                    const int row = u.pm * 256 + ai * 128 + wr * 64 + m * 16 + fr, col = u.pn * 256 + bj * 128 + wc * 32 + 8 * fq;
                    sv[m][bj] = *(const u32x4*)(P1 + (size_t)row * LDP + col);
                }
#pragma unroll
            for (int m = 0; m < 4; ++m)
#pragma unroll
                for (int bj = 0; bj < 2; ++bj) {
                    const int row = u.pm * 256 + ai * 128 + wr * 64 + m * 16 + fr, col = u.pn * 256 + bj * 128 + wc * 32 + 8 * fq;
                    float s[8]; unpack8(sv[m][bj], s);
                    const f32x4 v0 = acc[ai][bj][m][0], v1 = acc[ai][bj][m][1];
                    float r[8];
#pragma unroll
                    for (int e = 0; e < 4; ++e) { r[e] = s[e] * v0[e]; r[4 + e] = s[4 + e] * v1[e]; }
                    *(u32x4*)((bf16_t*)tmp + (size_t)row * 2048 + col) = pack8(r);
                }
            asm volatile("" ::: "memory");
        }
    }
};
struct EpiB {
    bf16_t* P1; const float* tmp;
    __device__ __forceinline__ void operator()(const AccT& acc, const pg8::Unit& u, int wr, int wc, int fr, int fq) const {
#pragma unroll
        for (int ai = 0; ai < 2; ++ai)
#pragma unroll
            for (int mh = 0; mh < 2; ++mh) {
                u32x4 sv[2][2], tv[2][2];
#pragma unroll
                for (int mm = 0; mm < 2; ++mm)
#pragma unroll
                    for (int bj = 0; bj < 2; ++bj) {
                        const int m = mh * 2 + mm;
                        const int row = u.pm * 256 + ai * 128 + wr * 64 + m * 16 + fr, col = u.pn * 256 + bj * 128 + wc * 32 + 8 * fq;
                        sv[mm][bj] = *(const u32x4*)(P1 + (size_t)row * LDP + 2048 + col);
                        tv[mm][bj] = *(const u32x4*)((const bf16_t*)tmp + (size_t)row * 2048 + col);
                    }
#pragma unroll
                for (int mm = 0; mm < 2; ++mm)
#pragma unroll
                    for (int bj = 0; bj < 2; ++bj) {
                        const int m = mh * 2 + mm;
                        const int row = u.pm * 256 + ai * 128 + wr * 64 + m * 16 + fr, col = u.pn * 256 + bj * 128 + wc * 32 + 8 * fq;
                        float s[8], t[8]; unpack8(sv[mm][bj], s); unpack8(tv[mm][bj], t);
                        const f32x4 v0 = acc[ai][bj][m][0], v1 = acc[ai][bj][m][1];
                        float r[8];
#pragma unroll
                        for (int e = 0; e < 4; ++e) { r[e] = t[e] + s[e] * v0[e]; r[4 + e] = t[4 + e] + s[4 + e] * v1[e]; }
                        *(u32x4*)(P1 + (size_t)row * LDP + 8192 + col) = pack8(r);
                    }
                asm volatile("" ::: "memory");
            }
    }
};
struct EpiO {
    float* OUTF; float* SSQ;
    __device__ __forceinline__ void operator()(const AccT& acc, const pg8::Unit& u, int wr, int wc, int fr, int fq) const {
#pragma unroll
        for (int ai = 0; ai < 2; ++ai)
#pragma unroll
            for (int m = 0; m < 4; ++m) {
                const int row = u.pm * 256 + ai * 128 + wr * 64 + m * 16 + fr;
                float s = 0.f;
#pragma unroll
                for (int bj = 0; bj < 2; ++bj) {
                    const int col = u.pn * 256 + bj * 128 + wc * 32 + 8 * fq;
                    const f32x4 v0 = acc[ai][bj][m][0], v1 = acc[ai][bj][m][1];
                    u32x4 wv; wv.x = cvt_pk_bf16(v0[0], v0[1]); wv.y = cvt_pk_bf16(v0[2], v0[3]); wv.z = cvt_pk_bf16(v1[0], v1[1]); wv.w = cvt_pk_bf16(v1[2], v1[3]);
                    *(u32x4*)((bf16_t*)OUTF + (size_t)row * 2048 + col) = wv;
#pragma unroll
                    for (int e = 0; e < 4; ++e) s += v0[e] * v0[e] + v1[e] * v1[e];
                }
                s += __shfl_xor(s, 16); s += __shfl_xor(s, 32);
                if (fq == 0) SSQ[(size_t)row * 32 + u.pn * 4 + wc] = s;
            }
    }
};

__device__ __forceinline__ int orig1(int n) {
    if (n < 8192) return n;
    if (n < 10240) return 12352 + (n - 8192);
    if (n < 12288) return 14400 + (n - 10240);
    const int j = n - 12288;
    if (j < 64) return 8192 + j;
    if (j < 80) return 16448 + (j - 64);
    return -1;
}
__device__ __forceinline__ int orig2(int n) {
    if (n < 4096) return 8256 + n;
    if (n < 8192) { const int q = (n - 4096) >> 8, l = (n - 4096) & 255; return l < 128 ? 16464 + 128 * q + l : 18512 + 128 * q + (l - 128); }
    if (n < 10240) return 20560 + (n - 8192);
    return 22608 + (n - 10240);
}
__device__ void transpose_tile(const float* __restrict__ W, int ldw, int K, bf16_t* __restrict__ Wt, int n0, int k0, int which, float* tl) {
    const int tid = threadIdx.x;
    const int nn = (tid & 31) * 4, n = n0 + nn;
    const int oc = which == 1 ? orig1(n) : (which == 2 ? orig2(n) : n);
    f32x4 v[8];
#pragma unroll
    for (int pass = 0; pass < 8; ++pass) {
        const int kk = (tid >> 5) + 16 * pass;
        v[pass] = (f32x4){0.f, 0.f, 0.f, 0.f};
        if (oc >= 0) v[pass] = *(const f32x4*)(W + (size_t)(k0 + kk) * ldw + oc);
    }
#pragma unroll
    for (int pass = 0; pass < 8; ++pass) {
        const int kk = (tid >> 5) + 16 * pass;
        tl[kk * 129 + nn] = v[pass][0]; tl[kk * 129 + nn + 1] = v[pass][1]; tl[kk * 129 + nn + 2] = v[pass][2]; tl[kk * 129 + nn + 3] = v[pass][3];
    }
    __syncthreads();
#pragma unroll
    for (int r = 0; r < 4; ++r) {
        const int pce = tid + 512 * r, nl = pce >> 4, kg = pce & 15;
        float f[8];
#pragma unroll
        for (int e = 0; e < 8; ++e) f[e] = tl[(kg * 8 + e) * 129 + nl];
        *(u32x4*)(Wt + (size_t)(n0 + nl) * K + k0 + kg * 8) = pack8(f);
    }
    __syncthreads();
}

__device__ void phase0(const Params& p, unsigned char* smem) {
    float* tl = (float*)smem;
    int tid_ = threadIdx.x; asm volatile("" : "+v"(tid_));
    const int tid = tid_;
    bf16_t* WT1 = (bf16_t*)(p.ws + OFF_WT1); bf16_t* WT2 = (bf16_t*)(p.ws + OFF_WT2);
    bf16_t* WTA = (bf16_t*)(p.ws + OFF_WTA); bf16_t* WTB = (bf16_t*)(p.ws + OFF_WTB); bf16_t* WTO = (bf16_t*)(p.ws + OFF_WTO);
    float* MODP = (float*)(p.ws + OFF_MODP);
    constexpr int NT1 = (N1 / 128) * 16, NT2 = (N2 / 128) * 16, NTA = 16 * 32, NTB = 16 * 16, NTO = 16 * 16, NADA = 192;
    constexpr int NU = NADA + NT1;
    for (int u = blockIdx.x; u < NU; u += gridDim.x) {
        if (u < NADA) {
            const int cb = u % 24, ks = u / 24;
            float* sl = tl;
            float* red = tl + 512;
            __syncthreads();
            { const int bb = tid >> 8, kk = tid & 255; sl[tid] = siluf_(p.c[bb * 2048 + ks * 256 + kk]); }
            __syncthreads();
            const int col = cb * 256 + (tid & 255), half = tid >> 8;
            float a0 = 0.f, a1 = 0.f;
            const float* wp = p.w_ada + (size_t)(ks * 256 + half * 128) * 6144 + col;
#pragma unroll 8
            for (int i = 0; i < 128; ++i) { const float w = wp[(size_t)i * 6144]; a0 += sl[half * 128 + i] * w; a1 += sl[256 + half * 128 + i] * w; }
            if (half == 1) { red[tid & 255] = a0; red[256 + (tid & 255)] = a1; }
            __syncthreads();
            if (half == 0) { MODP[(ks * 2 + 0) * 6144 + col] = a0 + red[tid]; MODP[(ks * 2 + 1) * 6144 + col] = a1 + red[256 + tid]; }
            __syncthreads();
        } else {
            int t = u - NADA;
            transpose_tile(p.w_in, INW, 2048, WT1, (t >> 4) * 128, (t & 15) * 128, 1, tl);
        }
    }
    (void)WT2; (void)WTA; (void)WTB; (void)WTO; (void)NT2; (void)NTA; (void)NTB; (void)NTO;
}

__device__ void late_transposes(const Params& p, unsigned char* smem, int idx, int nblk) {
    float* tl = (float*)smem;
    bf16_t* WT2 = (bf16_t*)(p.ws + OFF_WT2);
    bf16_t* WTA = (bf16_t*)(p.ws + OFF_WTA); bf16_t* WTB = (bf16_t*)(p.ws + OFF_WTB); bf16_t* WTO = (bf16_t*)(p.ws + OFF_WTO);
    constexpr int NT2 = (N2 / 128) * 16, NTA = 16 * 32, NTB = 16 * 16, NTO = 16 * 16;
    __syncthreads();
    for (int u = idx; u < NT2 + NTA + NTB + NTO; u += nblk) {
        int t = u;
        if (t < NT2) { transpose_tile(p.w_in, INW, 2048, WT2, (t >> 4) * 128, (t & 15) * 128, 2, tl); continue; }
        t -= NT2;
        if (t < NTA) { transpose_tile(p.wpa, 2048, 4096, WTA, (t >> 5) * 128, (t & 31) * 128, 0, tl); continue; }
        t -= NTA;
        if (t < NTB) { transpose_tile(p.wpb, 2048, 2048, WTB, (t >> 4) * 128, (t & 15) * 128, 0, tl); continue; }
        t -= NTB;
        transpose_tile(p.wout, 2048, 2048, WTO, (t >> 4) * 128, (t & 15) * 128, 0, tl);
    }
}

__device__ void phase1(const Params& p, unsigned char* smem) {
    float* shl = (float*)smem;
    float* scl = shl + 2048;
    const float* MODP = (const float*)(p.ws + OFF_MODP);
    bf16_t* H = (bf16_t*)p.out;
    int tid_ = threadIdx.x; asm volatile("" : "+v"(tid_));
    const int tid = tid_, lane = tid & 63, w = tid >> 6;
    for (int blk = blockIdx.x; blk < T_ / 64; blk += gridDim.x) {
        const int b = (blk * 64) >> 13;
        __syncthreads();
        for (int col = tid; col < 2048; col += 512) {
            float s0 = p.b_ada[col], s1 = 1.0f + p.b_ada[2048 + col];
#pragma unroll
            for (int ks = 0; ks < 8; ++ks) { s0 += MODP[(ks * 2 + b) * 6144 + col]; s1 += MODP[(ks * 2 + b) * 6144 + 2048 + col]; }
            shl[col] = s0; scl[col] = s1;
        }
        __syncthreads();
#pragma unroll 2
        for (int i = 0; i < 8; ++i) {
            const int row = blk * 64 + w * 8 + i;
            const float* xr = p.x + (size_t)row * 2048;
            f32x4 v[8]; float ss = 0.f;
#pragma unroll
            for (int e = 0; e < 8; ++e) { v[e] = *(const f32x4*)(xr + lane * 4 + 256 * e); ss += v[e][0] * v[e][0] + v[e][1] * v[e][1] + v[e][2] * v[e][2] + v[e][3] * v[e][3]; }
            ss = wave_sum(ss);
            const float rstd = rsqrtf(ss * (1.0f / 2048.0f) + EPS);
#pragma unroll
            for (int e = 0; e < 8; ++e) {
                const int col = lane * 4 + 256 * e;
                const f32x4 nw = *(const f32x4*)(p.npre + col), sh = *(const f32x4*)(shl + col), sc = *(const f32x4*)(scl + col);
                float r[4];
#pragma unroll
                for (int k = 0; k < 4; ++k) r[k] = v[e][k] * rstd * nw[k] * sc[k] + sh[k];
                *(u32x2*)(H + (size_t)row * 2048 + col) = pack4(r[0], r[1], r[2], r[3]);
            }
        }
    }
}

__device__ __forceinline__ void conv_item(const bf16_t* P1, const bf16_t* HB, int b, int c, int t, int col, const float* cw  , int cwstride, float (&y)[8]) {
    const size_t row0 = (size_t)b * SEQ_ + (size_t)c * 64;
    u32x4 xv[4];
    const int cp = c > 0 ? c - 1 : 0;
#pragma unroll
    for (int j = 0; j < 4; ++j) {
        const int tt = t - 3 + j;
        const bf16_t* src = (tt >= 0) ? (P1 + (row0 + tt) * LDP + col) : (HB + ((size_t)(b * 128 + cp) * 3 + (tt + 3)) * 10240 + col);
        xv[j] = *(const u32x4*)src;
        if (tt < 0 && c == 0) xv[j] = (u32x4){0u, 0u, 0u, 0u};
    }
#pragma unroll
    for (int e = 0; e < 8; ++e) y[e] = 0.f;
#pragma unroll
    for (int j = 0; j < 4; ++j) {
        float xf[8]; unpack8(xv[j], xf);
        const f32x4 w0 = *(const f32x4*)(cw + j * cwstride), w1 = *(const f32x4*)(cw + j * cwstride + 4);
#pragma unroll
        for (int e = 0; e < 4; ++e) { y[e] += xf[e] * w0[e]; y[4 + e] += xf[4 + e] * w1[e]; }
    }
#pragma unroll
    for (int e = 0; e < 8; ++e) y[e] = siluf_(y[e]);
}

__device__ void prep_gdn(const Params& p, unsigned char* smem, int unit0) {
    bf16_t* P1 = (bf16_t*)(p.ws + OFF_P1); const bf16_t* HB = (const bf16_t*)(p.ws + OFF_HB);
    const float* SM = (const float*)(p.ws + OFF_SM); bf16_t* WB = (bf16_t*)(p.ws + OFF_WB); float* GC = (float*)(p.ws + OFF_GC);
    bf16_t* AT = (bf16_t*)p.out + (size_t)T_ * 2048;
    int tid_ = threadIdx.x; asm volatile("" : "+v"(tid_));
    const int tid = tid_, hb = tid >> 8, ht = tid & 255, lane = tid & 63, wl = (tid >> 6) & 3, l15 = lane & 15, quad = lane >> 4;
    float* cwl = (float*)smem;
    unsigned char* hbase = smem + 4096 + hb * 69120;
    bf16_t* Qn = (bf16_t*)hbase;
    bf16_t* Kn = Qn + 64 * 136;
    float* KKl = (float*)(Kn + 64 * 136);
    float* QKl = KKl + 64 * 64;
    float* gcl = QKl + 64 * 64;
    float* btl = gcl + 128;
    float* btg = btl + 128;
    const int unit = unit0 + hb;
    const int c = unit & 127, qkh = (unit >> 7) & 15, b = unit >> 11;
    const size_t row0 = (size_t)b * SEQ_ + (size_t)c * 64;
    const int hs = ht >> 7, js = ht & 127, hsol = qkh * 2 + hs;
    bf16_t xrw[67];
    float cw0, cw1, cw2, cw3;
    {
        const int col = 4096 + hsol * 128 + js;
#pragma unroll
        for (int tt = 0; tt < 3; ++tt) xrw[tt] = c > 0 ? HB[((size_t)(b * 128 + (c - 1)) * 3 + tt) * 10240 + col] : (bf16_t)0;
#pragma unroll
        for (int tt = 0; tt < 64; ++tt) xrw[3 + tt] = P1[(row0 + tt) * LDP + col];
        cw0 = p.gconv[col]; cw1 = p.gconv[8192 + col]; cw2 = p.gconv[2 * 8192 + col]; cw3 = p.gconv[3 * 8192 + col];
    }
    __syncthreads();
    for (int i = tid; i < 1024; i += 512) { const int j = i >> 8, ch = i & 255; cwl[i] = p.gconv[(size_t)j * 8192 + (ch >> 7) * 2048 + qkh * 128 + (ch & 127)]; }
    __syncthreads();
#pragma unroll
    for (int r = 0; r < 8; ++r) {
        const int item = ht + 256 * r, chg = item & 15, t = (item >> 4) & 63, which = item >> 10;
        float y[8];
        conv_item(P1, HB, b, c, t, which * 2048 + qkh * 128 + chg * 8, cwl + which * 128 + chg * 8, 256, y);
        float ss = 0.f;
#pragma unroll
        for (int e = 0; e < 8; ++e) ss += y[e] * y[e];
        ss += __shfl_xor(ss, 1); ss += __shfl_xor(ss, 2); ss += __shfl_xor(ss, 4); ss += __shfl_xor(ss, 8);
        const float sc = rsqrtf(ss + EPS) * (which == 0 ? 0.08838834764831845f : 1.0f);
#pragma unroll
        for (int e = 0; e < 8; ++e) y[e] *= sc;
        *(u32x4*)((which == 0 ? Qn : Kn) + t * 136 + chg * 8) = pack8(y);
    }
    if (wl < 2) {
        const int h = qkh * 2 + wl;
        const float ap = SM[(size_t)h * T_ + row0 + lane], bp = SM[(size_t)(32 + h) * T_ + row0 + lane];
        const float xx = ap + p.dtb[h];
        const float sp = fmaxf(xx, 0.f) + log1pf(expf(-fabsf(xx)));
        const float g = -expf(p.Alog[h]) * sp;
        const float gcum = wave_scan_add(g, lane);
        const float beta_ = sigmoidf_(bp);
        gcl[wl * 64 + lane] = gcum; btl[wl * 64 + lane] = beta_; btg[wl * 64 + lane] = beta_ * __expf(gcum);
        GC[(size_t)(b * 32 + h) * SEQ_ + c * 64 + lane] = gcum;
    }
    __syncthreads();
#pragma unroll
    for (int i = 0; i < 8; ++i) {
        const int idx = wl * 8 + i, mat = idx >> 4, ti = (idx >> 2) & 3, tj = idx & 3;
        const bf16_t* Am = mat ? Qn : Kn;
        f32x4 a = (f32x4){0.f, 0.f, 0.f, 0.f};
#pragma unroll
        for (int kk = 0; kk < 4; ++kk) {
            const bf16x8 af = *(const bf16x8*)(Am + (16 * ti + l15) * 136 + kk * 32 + quad * 8);
            const bf16x8 bf = *(const bf16x8*)(Kn + (16 * tj + l15) * 136 + kk * 32 + quad * 8);
            a = mfma16(af, bf, a);
        }
        float* dst = mat ? QKl : KKl;
#pragma unroll
        for (int j = 0; j < 4; ++j) dst[(16 * ti + quad * 4 + j) * 64 + 16 * tj + l15] = a[j];
    }
    __syncthreads();
    {
        const int j = ht & 63;
        const float g0j = gcl[j], g1j = gcl[64 + j];
        bf16_t* atp0 = AT + ((size_t)(b * 32 + qkh * 2) * 128 + c) * 4096;
        bf16_t* atp1 = atp0 + (size_t)128 * 4096;
#pragma unroll
        for (int r = 0; r < 16; ++r) {
            const int i = (ht >> 6) + 4 * r;
            const float kk = KKl[i * 64 + j], qk = QKl[i * 64 + j];
            const float d0 = __expf(fminf(gcl[i] - g0j, 0.f)), d1 = __expf(fminf(gcl[64 + i] - g1j, 0.f));
            KKl[i * 64 + j] = (j < i) ? btl[i] * kk * d0 : 0.f;
            QKl[i * 64 + j] = (j < i) ? btl[64 + i] * kk * d1 : 0.f;
            atp0[i * 64 + j] = f2bf((j <= i) ? qk * d0 : 0.f);
            atp1[i * 64 + j] = f2bf((j <= i) ? qk * d1 : 0.f);
        }
    }
    f32x2 sol[64];
    {
        const float* bts = btl + hs * 64; const float* bgs = btg + hs * 64;
#pragma unroll
        for (int t = 0; t < 64; ++t) {
            const float y = cw0 * bf2f(xrw[t]) + cw1 * bf2f(xrw[t + 1]) + cw2 * bf2f(xrw[t + 2]) + cw3 * bf2f(xrw[t + 3]);
            sol[t].x = siluf_(y) * bts[t];
            sol[t].y = bf2f(Kn[t * 136 + js]) * bgs[t];
        }
    }
    __syncthreads();
    {
        const float* Ah = KKl + hs * 4096;
#pragma unroll
        for (int i = 1; i < 64; ++i) {
            f32x4 av[16];
#pragma unroll
            for (int j4 = 0; j4 < (i + 3) / 4; ++j4) av[j4] = *(const f32x4*)(Ah + i * 64 + j4 * 4);
            f32x2 s0 = sol[i], s1 = (f32x2){0.f, 0.f};
#pragma unroll
            for (int j4 = 0; j4 < (i + 3) / 4; ++j4) {
                s0 -= (f32x2){av[j4][0], av[j4][0]} * sol[j4 * 4 + 0]; s1 -= (f32x2){av[j4][1], av[j4][1]} * sol[j4 * 4 + 1];
                s0 -= (f32x2){av[j4][2], av[j4][2]} * sol[j4 * 4 + 2]; s1 -= (f32x2){av[j4][3], av[j4][3]} * sol[j4 * 4 + 3];
            }
            sol[i] = s0 + s1;
        }
        bf16_t* du = P1 + row0 * LDP + 4096 + hsol * 128 + js;
        bf16_t* dw = WB + row0 * 4096 + hsol * 128 + js;
#pragma unroll
        for (int t = 0; t < 64; ++t) { du[(size_t)t * LDP] = f2bf(sol[t].x); dw[(size_t)t * 4096] = f2bf(sol[t].y); if ((t & 7) == 7) asm volatile("" ::: "memory"); }
    }
#pragma unroll
    for (int r = 0; r < 4; ++r) {
        const int pce = ht + 256 * r;
        { const int t = pce >> 4, seg = pce & 15; *(u32x4*)(P1 + (row0 + t) * LDP + qkh * 128 + seg * 8) = *(const u32x4*)(Qn + t * 136 + seg * 8); }
        { const int dk = pce >> 3, t0 = (pce & 7) * 8;
          float f[8];
#pragma unroll
          for (int e = 0; e < 8; ++e) f[e] = bf2f(Kn[(t0 + e) * 136 + dk]);
          *(u32x4*)(P1 + (row0 + (pce >> 4)) * LDP + 2048 + qkh * 128 + (pce & 15) * 8) = pack8(f); }
    }
}

__device__ void prep_mlstm(const Params& p, unsigned char* smem, int unit0) {
    bf16_t* P1 = (bf16_t*)(p.ws + OFF_P1); const bf16_t* HB = (const bf16_t*)(p.ws + OFF_HB); const float* SM = (const float*)(p.ws + OFF_SM);
    bf16_t* KT = (bf16_t*)(p.ws + OFF_WT1);
    f32x4* MS = (f32x4*)(p.ws + OFF_WT1 + 33554432);
    int tid_ = threadIdx.x; asm volatile("" : "+v"(tid_));
    const int tid = tid_, hb = tid >> 8, ht = tid & 255, lane = tid & 63, wl = (tid >> 6) & 3;
    float* cwl = (float*)smem;
    bf16_t* Kn = (bf16_t*)(smem + 4096 + hb * 17408);
    const int unit = unit0 + hb;
    const int c = unit & 127, hd = (unit >> 7) & 7, b = unit >> 10;
    const size_t row0 = (size_t)b * SEQ_ + (size_t)c * 64;
    __syncthreads();
    for (int i = tid; i < 1024; i += 512) { const int j = i >> 8, ch = i & 255; cwl[i] = p.mconv[(size_t)j * 2048 + (ch >> 7) * 1024 + hd * 128 + (ch & 127)]; }
    __syncthreads();
    u32x4 res[8];
#pragma unroll
    for (int r = 0; r < 8; ++r) {
        const int item = ht + 256 * r, chg = item & 15, t = (item >> 4) & 63, which = item >> 10;
        float y[8];
        conv_item(P1, HB, b, c, t, 8192 + which * 1024 + hd * 128 + chg * 8, cwl + which * 128 + chg * 8, 256, y);
        if (which == 0) {
#pragma unroll
            for (int e = 0; e < 8; ++e) y[e] *= 0.08838834764831845f;
        }
        res[r] = pack8(y);
        if (which == 1) *(u32x4*)(Kn + t * 136 + chg * 8) = res[r];
    }
    if (wl == 0) {
        const float ip = SM[(size_t)(64 + hd) * T_ + row0 + lane] + p.mbi[hd], fp = SM[(size_t)(72 + hd) * T_ + row0 + lane] + p.mbf[hd];
        const float lf = fminf(fp, 0.f) - log1pf(expf(-fabsf(fp)));
        const float bc = wave_scan_add(lf, lane);
        const float av = ip - bc;
        const float cm = wave_scan_max(av, lane);
        MS[(size_t)(b * 8 + hd) * SEQ_ + c * 64 + lane] = (f32x4){bc, av, cm, 0.f};
    }
    __syncthreads();
#pragma unroll
    for (int r = 0; r < 8; ++r) {
        const int item = ht + 256 * r, chg = item & 15, t = (item >> 4) & 63, which = item >> 10;
        *(u32x4*)(P1 + (row0 + t) * LDP + 8192 + which * 1024 + hd * 128 + chg * 8) = res[r];
    }
#pragma unroll
    for (int r = 0; r < 4; ++r) {
        const int pce = ht + 256 * r, dk = pce >> 3, t0 = (pce & 7) * 8;
        float f[8];
#pragma unroll
        for (int e = 0; e < 8; ++e) f[e] = bf2f(Kn[(t0 + e) * 136 + dk]);
        *(u32x4*)(KT + ((size_t)((b * 8 + hd) * 128 + c)) * 8192 + pce * 8) = pack8(f);
    }
}

__device__ void gdn_scan(const Params& p, unsigned char* smem, int unit) {
    bf16_t* P1 = (bf16_t*)(p.ws + OFF_P1); const bf16_t* WB = (const bf16_t*)(p.ws + OFF_WB); const float* GC = (const float*)(p.ws + OFF_GC);
    float* RSA = (float*)(p.ws + OFF_RSA);
    const bf16_t* AT = (const bf16_t*)p.out + (size_t)T_ * 2048;
    bf16_t* Wl = (bf16_t*)smem;
    bf16_t* Ql = Wl + 64 * 136;
    bf16_t* St = Ql + 64 * 136;
    bf16_t* Kt = St + 64 * 136;
    bf16_t* At = Kt + 128 * 72;
    bf16_t* Vt = At + 64 * 72;
    bf16_t* V2 = Vt + 64 * 72;
    bf16_t* Ul = V2 + 64 * 72;
    bf16_t* Ol = Ul + 64 * 72;
    float* gcl = (float*)(Ol + 64 * 72);
    int tid_ = threadIdx.x; asm volatile("" : "+v"(tid_));
    const int tid = tid_, lane = tid & 63, w = tid >> 6, l15 = lane & 15, quad = lane >> 4;
    const int bh = unit >> 1, b = bh >> 5, h = bh & 31, qkh = h >> 1, sl = unit & 1, dv0 = sl * 64;
    const size_t rowb = (size_t)b * SEQ_;
    u32x4 rw[2][2], rq[2][2], rk[2][2], ra[2], ru[2]; float rg[2];
#define GDN_ISSUE(S, cc) do { const size_t r0_ = rowb + (size_t)(cc) * 64; \
        _Pragma("unroll") for (int i_ = 0; i_ < 2; ++i_) { const int p_ = tid + 512 * i_, t_ = p_ >> 4, s_ = p_ & 15; \
            rw[S][i_] = *(const u32x4*)(WB + (r0_ + t_) * 4096 + h * 128 + s_ * 8); \
            rq[S][i_] = *(const u32x4*)(P1 + (r0_ + t_) * LDP + qkh * 128 + s_ * 8); \
            rk[S][i_] = *(const u32x4*)(P1 + (r0_ + t_) * LDP + 2048 + qkh * 128 + s_ * 8); } \
        ra[S] = *(const u32x4*)(AT + ((size_t)(b * 32 + h) * 128 + (cc)) * 4096 + tid * 8); \
        ru[S] = *(const u32x4*)(P1 + (r0_ + (tid >> 3)) * LDP + 4096 + h * 128 + dv0 + (tid & 7) * 8); \
        if (w == 0) rg[S] = GC[(size_t)(b * 32 + h) * SEQ_ + (cc) * 64 + lane]; } while (0)
#define GDN_STAGE1(S) do { \
        _Pragma("unroll") for (int i_ = 0; i_ < 2; ++i_) { const int p_ = tid + 512 * i_, t_ = p_ >> 4, s_ = p_ & 15; \
            *(u32x4*)(Wl + t_ * 136 + s_ * 8) = rw[S][i_]; *(u32x4*)(Ql + t_ * 136 + s_ * 8) = rq[S][i_]; } \
        *(u32x4*)(Ul + (tid >> 3) * 72 + (tid & 7) * 8) = ru[S]; \
        if (w == 0) gcl[lane] = rg[S]; } while (0)
#define GDN_STAGE2(S) do { \
        _Pragma("unroll") for (int i_ = 0; i_ < 2; ++i_) { const int p_ = tid + 512 * i_; \
            *(u32x4*)(Kt + (p_ >> 3) * 72 + (p_ & 7) * 8) = rk[S][i_]; } \
        *(u32x4*)(At + (tid >> 3) * 72 + (tid & 7) * 8) = ra[S]; } while (0)
    f32x4 Sacc[4];
#pragma unroll
    for (int n = 0; n < 4; ++n) Sacc[n] = (f32x4){0.f, 0.f, 0.f, 0.f};
    __syncthreads();
    for (int i = tid; i < 64 * 136 / 8; i += 512) *(u32x4*)(St + i * 8) = (u32x4){0u, 0u, 0u, 0u};
    GDN_ISSUE(0, 0); GDN_STAGE1(0); GDN_STAGE2(0);
    GDN_ISSUE(0, 1); GDN_ISSUE(1, 2);
    __syncthreads();
    const int tt = w >> 1, nb = (w & 1) * 2;
    for (int c2 = 0; c2 < 128; c2 += 2) {
#pragma unroll
      for (int par = 0; par < 2; ++par) {
        const int c = c2 + par;
        f32x4 ws[2], qs[2];
#pragma unroll
        for (int n = 0; n < 2; ++n) { ws[n] = (f32x4){0.f, 0.f, 0.f, 0.f}; qs[n] = (f32x4){0.f, 0.f, 0.f, 0.f}; }
        {
            bf16x8 aw[4], aq[4], bs[2][4];
#pragma unroll
            for (int kk = 0; kk < 4; ++kk) {
                aw[kk] = *(const bf16x8*)(Wl + (16 * tt + l15) * 136 + kk * 32 + quad * 8);
                bs[0][kk] = *(const bf16x8*)(St + (16 * nb + l15) * 136 + kk * 32 + quad * 8);
                bs[1][kk] = *(const bf16x8*)(St + (16 * (nb + 1) + l15) * 136 + kk * 32 + quad * 8);
                aq[kk] = *(const bf16x8*)(Ql + (16 * tt + l15) * 136 + kk * 32 + quad * 8);
            }
#pragma unroll
            for (int kk = 0; kk < 4; ++kk)
#pragma unroll
                for (int n = 0; n < 2; ++n) ws[n] = mfma16(aw[kk], bs[n][kk], ws[n]);
#pragma unroll
            for (int kk = 0; kk < 4; ++kk)
#pragma unroll
                for (int n = 0; n < 2; ++n) qs[n] = mfma16(aq[kk], bs[n][kk], qs[n]);
        }
        const float gl = gcl[63];
        float gr[4];
#pragma unroll
        for (int j = 0; j < 4; ++j) gr[j] = gcl[16 * tt + quad * 4 + j];
#pragma unroll
        for (int n = 0; n < 2; ++n) {
            const int dvc = 16 * (nb + n) + l15;
            float vn[4], v2[4];
#pragma unroll
            for (int j = 0; j < 4; ++j) {
                vn[j] = bf2f(Ul[(16 * tt + quad * 4 + j) * 72 + dvc]) - ws[n][j];
                v2[j] = vn[j] * __expf(gl - gr[j]);
                qs[n][j] *= __expf(gr[j]);
            }
            *(u32x2*)(Vt + dvc * 72 + 16 * tt + quad * 4) = pack4(vn[0], vn[1], vn[2], vn[3]);
            *(u32x2*)(V2 + dvc * 72 + 16 * tt + quad * 4) = pack4(v2[0], v2[1], v2[2], v2[3]);
        }
        __syncthreads();
        bf16x8 ak2[2], bv2[4][2];
        {
            bf16x8 aa[2], bv[2][2];
#pragma unroll
            for (int kk = 0; kk < 2; ++kk) {
                aa[kk] = *(const bf16x8*)(At + (16 * tt + l15) * 72 + kk * 32 + quad * 8);
                bv[0][kk] = *(const bf16x8*)(Vt + (16 * nb + l15) * 72 + kk * 32 + quad * 8);
                bv[1][kk] = *(const bf16x8*)(Vt + (16 * (nb + 1) + l15) * 72 + kk * 32 + quad * 8);
            }
#pragma unroll
            for (int kk = 0; kk < 2; ++kk) {
                ak2[kk] = *(const bf16x8*)(Kt + (16 * w + l15) * 72 + kk * 32 + quad * 8);
#pragma unroll
                for (int n = 0; n < 4; ++n) bv2[n][kk] = *(const bf16x8*)(V2 + (16 * n + l15) * 72 + kk * 32 + quad * 8);
            }
#pragma unroll
            for (int kk = 0; kk < 2; ++kk)
#pragma unroll
                for (int n = 0; n < 2; ++n) qs[n] = mfma16(aa[kk], bv[n][kk], qs[n]);
        }
#pragma unroll
        for (int n = 0; n < 2; ++n)
#pragma unroll
            for (int j = 0; j < 4; ++j) Ol[(16 * tt + quad * 4 + j) * 72 + 16 * (nb + n) + l15] = f2bf(qs[n][j]);
        const float gt = __expf(gl);
#pragma unroll
        for (int n = 0; n < 4; ++n) Sacc[n] *= gt;
#pragma unroll
        for (int kk = 0; kk < 2; ++kk)
#pragma unroll
            for (int n = 0; n < 4; ++n) Sacc[n] = mfma16(ak2[kk], bv2[n][kk], Sacc[n]);
#pragma unroll
        for (int n = 0; n < 4; ++n) *(u32x2*)(St + (16 * n + l15) * 136 + 16 * w + quad * 4) = pack4(Sacc[n][0], Sacc[n][1], Sacc[n][2], Sacc[n][3]);
        if (c + 1 < 128) { if (par == 0) GDN_STAGE1(0); else GDN_STAGE1(1); }
        __syncthreads();
        {
            const int t = tid >> 3, seg = tid & 7;
            const u32x4 o = *(const u32x4*)(Ol + t * 72 + seg * 8);
            const size_t row = rowb + (size_t)c * 64 + t;
            *(u32x4*)(P1 + row * LDP + 4096 + h * 128 + dv0 + seg * 8) = o;
            float f[8]; unpack8(o, f);
            float ss = 0.f;
#pragma unroll
            for (int e = 0; e < 8; ++e) ss += f[e] * f[e];
            ss += __shfl_xor(ss, 1); ss += __shfl_xor(ss, 2); ss += __shfl_xor(ss, 4);
            if (seg == 0) RSA[(size_t)((b * 32 + h) * 2 + sl) * SEQ_ + c * 64 + t] = ss;
        }
        if (par == 0) { if (c + 1 < 128) GDN_STAGE2(0); if (c + 3 < 128) GDN_ISSUE(0, c + 3); }
        else          { if (c + 1 < 128) GDN_STAGE2(1); if (c + 3 < 128) GDN_ISSUE(1, c + 3); }
      }
    }
#undef GDN_ISSUE
#undef GDN_STAGE1
#undef GDN_STAGE2
}

__device__ void mlstm_scan(const Params& p, unsigned char* smem, int unit) {
    bf16_t* P1 = (bf16_t*)(p.ws + OFF_P1); float* RSB = (float*)(p.ws + OFF_RSB);
    const bf16_t* KT = (const bf16_t*)(p.ws + OFF_WT1); const f32x4* MS = (const f32x4*)(p.ws + OFF_WT1 + 33554432);
    bf16_t* Qc = (bf16_t*)smem;
    bf16_t* Kc = Qc + 64 * 136;
    bf16_t* Ct = Kc + 64 * 136;
    bf16_t* Kt = Ct + 48 * 136;
    bf16_t* Sl = Kt + 128 * 72;
    bf16_t* Vx = Sl + 64 * 72;
    bf16_t* V2 = Vx + 48 * 72;
    bf16_t* Ol = V2 + 48 * 72;
    float* aL = (float*)(Ol + 64 * 40);
    float* ML = aL + 64; float* wiL = ML + 64; float* enL = wiL + 64;
    int tid_ = threadIdx.x; asm volatile("" : "+v"(tid_));
    const int tid = tid_, lane = tid & 63, w = tid >> 6, l15 = lane & 15, quad = lane >> 4;
    const int bh = unit >> 3, b = bh >> 3, hd = bh & 7, sl = unit & 7, dv0 = sl * 32;
    const size_t rowb = (size_t)b * SEQ_;
    u32x4 rq[2][2], rk[2][2], rkt[2][2], rv[2]; f32x4 rms[2];
    float m_state = 0.f, cd = 1.f;
#define ML_ISSUE(S, cc) do { const size_t r0_ = rowb + (size_t)(cc) * 64; \
        _Pragma("unroll") for (int i_ = 0; i_ < 2; ++i_) { const int p_ = tid + 512 * i_, t_ = p_ >> 4, s_ = p_ & 15; \
            rq[S][i_] = *(const u32x4*)(P1 + (r0_ + t_) * LDP + 8192 + hd * 128 + s_ * 8); \
            rk[S][i_] = *(const u32x4*)(P1 + (r0_ + t_) * LDP + 9216 + hd * 128 + s_ * 8); \
            rkt[S][i_] = *(const u32x4*)(KT + ((size_t)((b * 8 + hd) * 128 + (cc))) * 8192 + p_ * 8); } \
        if (tid < 256) rv[S] = *(const u32x4*)(P1 + (r0_ + (tid >> 2)) * LDP + 10240 + hd * 256 + dv0 + (tid & 3) * 8); \
        rms[S] = MS[(size_t)(b * 8 + hd) * SEQ_ + (cc) * 64 + lane]; } while (0)
    float wk_s = 0.f, wi_s = 0.f, en_s = 0.f;
#define ML_STAGE1(S) do { \
        const float bc_ = rms[S].x, a_ = rms[S].y, cm_ = rms[S].z; \
        const float M_ = fmaxf(m_state, cm_); \
        const float M63_ = __shfl(M_, 63), bl_ = __shfl(bc_, 63); \
        wk_s = __expf(a_ - M63_); wi_s = __expf(m_state - M_); en_s = __expf(-(bc_ + M_)); \
        if (w == 0) { aL[lane] = a_; ML[lane] = M_; } \
        cd = __expf(m_state - M63_); m_state = bl_ + M63_; \
        _Pragma("unroll") for (int i_ = 0; i_ < 2; ++i_) { const int p_ = tid + 512 * i_, t_ = p_ >> 4, s_ = p_ & 15; \
            *(u32x4*)(Qc + t_ * 136 + s_ * 8) = rq[S][i_]; *(u32x4*)(Kc + t_ * 136 + s_ * 8) = rk[S][i_]; } } while (0)
#define ML_STAGE2(S) do { \
        if (w == 0) { wiL[lane] = wi_s; enL[lane] = en_s; } \
        _Pragma("unroll") for (int i_ = 0; i_ < 2; ++i_) { const int p_ = tid + 512 * i_; \
            *(u32x4*)(Kt + (p_ >> 3) * 72 + (p_ & 7) * 8) = rkt[S][i_]; } \
        if (tid < 256) { const int t_ = tid >> 2, d0_ = (tid & 3) * 8; const float wkt_ = __shfl(wk_s, t_); \
            _Pragma("unroll") for (int e_ = 0; e_ < 8; ++e_) { const int ee_ = (e_ + 2 * (tid & 3)) & 7; \
                const unsigned w01_ = (ee_ & 2) ? rv[S].y : rv[S].x, w23_ = (ee_ & 2) ? rv[S].w : rv[S].z, ws_ = (ee_ & 4) ? w23_ : w01_; \
                const unsigned hv_ = (ee_ & 1) ? (ws_ >> 16) : (ws_ & 0xffffu); \
                Vx[(d0_ + ee_) * 72 + t_] = (bf16_t)hv_; V2[(d0_ + ee_) * 72 + t_] = f2bf(__uint_as_float(hv_ << 16) * wkt_); } } \
        if (w == 4) { Vx[32 * 72 + lane] = (bf16_t)0x3f80u; V2[32 * 72 + lane] = f2bf(wk_s); } } while (0)
    f32x4 Cacc[3];
#pragma unroll
    for (int n = 0; n < 3; ++n) Cacc[n] = (f32x4){0.f, 0.f, 0.f, 0.f};
    __syncthreads();
    for (int i = tid; i < 48 * 136 / 8; i += 512) *(u32x4*)(Ct + i * 8) = (u32x4){0u, 0u, 0u, 0u};
    for (int i = tid; i < 2 * 48 * 72 / 8; i += 512) *(u32x4*)(Vx + i * 8) = (u32x4){0u, 0u, 0u, 0u};
    __syncthreads();
    ML_ISSUE(0, 0); ML_STAGE1(0); ML_STAGE2(0);
    ML_ISSUE(0, 1); ML_ISSUE(1, 2);
    __syncthreads();
    const int tt = w >> 1, half = w & 1;
    for (int c2 = 0; c2 < 128; c2 += 2) {
#pragma unroll
      for (int par = 0; par < 2; ++par) {
        const int c = c2 + par;
        const float cd_cur = cd;
#pragma unroll
        for (int e = 0; e < 2; ++e) {
            const int idx = 2 * w + e, tj = idx >> 2, ti = idx & 3;
            f32x4 a = (f32x4){0.f, 0.f, 0.f, 0.f};
            if (tj <= ti) {
                bf16x8 ak[4], bq[4];
#pragma unroll
                for (int kk = 0; kk < 4; ++kk) {
                    ak[kk] = *(const bf16x8*)(Kc + (16 * tj + l15) * 136 + kk * 32 + quad * 8);
                    bq[kk] = *(const bf16x8*)(Qc + (16 * ti + l15) * 136 + kk * 32 + quad * 8);
                }
#pragma unroll
                for (int kk = 0; kk < 4; ++kk) a = mfma16(ak[kk], bq[kk], a);
            }
            const int ig = 16 * ti + l15;
            const float Mi = ML[ig];
            float sv[4];
#pragma unroll
            for (int j = 0; j < 4; ++j) { const int jg = 16 * tj + quad * 4 + j; sv[j] = (jg <= ig) ? a[j] * __expf(fminf(aL[jg] - Mi, 0.f)) : 0.f; }
            *(u32x2*)(Sl + ig * 72 + 16 * tj + quad * 4) = pack4(sv[0], sv[1], sv[2], sv[3]);
        }
        f32x4 qc[2];
        qc[0] = (f32x4){0.f, 0.f, 0.f, 0.f}; qc[1] = (f32x4){0.f, 0.f, 0.f, 0.f};
        {
            bf16x8 aq[4], b0[4], b1[4];
#pragma unroll
            for (int kk = 0; kk < 4; ++kk) {
                aq[kk] = *(const bf16x8*)(Qc + (16 * tt + l15) * 136 + kk * 32 + quad * 8);
                b0[kk] = *(const bf16x8*)(Ct + (16 * half + l15) * 136 + kk * 32 + quad * 8);
                b1[kk] = *(const bf16x8*)(Ct + (32 + l15) * 136 + kk * 32 + quad * 8);
            }
#pragma unroll
            for (int kk = 0; kk < 4; ++kk) { qc[0] = mfma16(aq[kk], b0[kk], qc[0]); qc[1] = mfma16(aq[kk], b1[kk], qc[1]); }
        }
        __syncthreads();
        bf16x8 ak3[2], bv3[3][2];
        {
            float wi[4], en[4];
#pragma unroll
            for (int j = 0; j < 4; ++j) { wi[j] = wiL[16 * tt + quad * 4 + j]; en[j] = enL[16 * tt + quad * 4 + j]; qc[0][j] *= wi[j]; qc[1][j] *= wi[j]; }
            {
                bf16x8 as[2], b0[2], b1[2];
#pragma unroll
                for (int kk = 0; kk < 2; ++kk) {
                    as[kk] = *(const bf16x8*)(Sl + (16 * tt + l15) * 72 + kk * 32 + quad * 8);
                    b0[kk] = *(const bf16x8*)(Vx + (16 * half + l15) * 72 + kk * 32 + quad * 8);
                    b1[kk] = *(const bf16x8*)(Vx + (32 + l15) * 72 + kk * 32 + quad * 8);
                }
#pragma unroll
                for (int kk = 0; kk < 2; ++kk) {
                    ak3[kk] = *(const bf16x8*)(Kt + (16 * w + l15) * 72 + kk * 32 + quad * 8);
#pragma unroll
                    for (int n = 0; n < 3; ++n) bv3[n][kk] = *(const bf16x8*)(V2 + (16 * n + l15) * 72 + kk * 32 + quad * 8);
                }
#pragma unroll
                for (int kk = 0; kk < 2; ++kk) { qc[0] = mfma16(as[kk], b0[kk], qc[0]); qc[1] = mfma16(as[kk], b1[kk], qc[1]); }
            }
#pragma unroll
            for (int j = 0; j < 4; ++j) {
                const float den = __shfl(qc[1][j], quad * 16);
                const float hv = qc[0][j] * __builtin_amdgcn_rcpf(fmaxf(fabsf(den), en[j]));
                Ol[(16 * tt + quad * 4 + j) * 40 + 16 * half + l15] = f2bf(hv);
            }
        }
#pragma unroll
        for (int n = 0; n < 3; ++n) Cacc[n] *= cd_cur;
#pragma unroll
        for (int kk = 0; kk < 2; ++kk)
#pragma unroll
            for (int n = 0; n < 3; ++n) Cacc[n] = mfma16(ak3[kk], bv3[n][kk], Cacc[n]);
#pragma unroll
        for (int n = 0; n < 3; ++n) *(u32x2*)(Ct + (16 * n + l15) * 136 + 16 * w + quad * 4) = pack4(Cacc[n][0], Cacc[n][1], Cacc[n][2], Cacc[n][3]);
        if (c + 1 < 128) { if (par == 0) ML_STAGE1(0); else ML_STAGE1(1); }
        __syncthreads();
        if (tid < 256) {
            const int t = tid >> 2, seg = tid & 3;
            const u32x4 o = *(const u32x4*)(Ol + t * 40 + seg * 8);
            const size_t row = rowb + (size_t)c * 64 + t;
            *(u32x4*)(P1 + row * LDP + 10240 + hd * 256 + dv0 + seg * 8) = o;
            float f[8]; unpack8(o, f);
            float ss = 0.f;
#pragma unroll
            for (int e = 0; e < 8; ++e) ss += f[e] * f[e];
            ss += __shfl_xor(ss, 1); ss += __shfl_xor(ss, 2);
            if (seg == 0) RSB[(size_t)((b * 8 + hd) * 8 + sl) * SEQ_ + c * 64 + t] = ss;
        }
        if (par == 0) { if (c + 1 < 128) ML_STAGE2(0); if (c + 3 < 128) ML_ISSUE(0, c + 3); }
        else          { if (c + 1 < 128) ML_STAGE2(1); if (c + 3 < 128) ML_ISSUE(1, c + 3); }
      }
    }
#undef ML_ISSUE
#undef ML_STAGE1
#undef ML_STAGE2
}

__device__ void phase_final(const Params& p, unsigned char* smem) {
    float* gl = (float*)smem;
    const float* MODP = (const float*)(p.ws + OFF_MODP);
    const float* OUTF = (const float*)(p.ws + OFF_WB); const float* SSQ = (const float*)(p.ws + OFF_SSQ);
    int tid_ = threadIdx.x; asm volatile("" : "+v"(tid_));
    const int tid = tid_, lane = tid & 63, w = tid >> 6;
    for (int blk = blockIdx.x; blk < T_ / 64; blk += gridDim.x) {
        const int b = (blk * 64) >> 13;
        __syncthreads();
        for (int col = tid; col < 2048; col += 512) {
            float s0 = p.b_ada[4096 + col];
#pragma unroll
            for (int ks = 0; ks < 8; ++ks) s0 += MODP[(ks * 2 + b) * 6144 + 4096 + col];
            gl[col] = s0;
        }
        __syncthreads();
#pragma unroll 2
        for (int i = 0; i < 8; ++i) {
            const int row = blk * 64 + w * 8 + i;
            float ss = (lane < 32) ? SSQ[(size_t)row * 32 + lane] : 0.f;
            ss = wave_sum(ss);
            const float rstd = rsqrtf(ss * (1.0f / 2048.0f) + EPS);
#pragma unroll
            for (int e = 0; e < 8; ++e) {
                const int col = lane * 4 + 256 * e;
                const f32x4 xv = *(const f32x4*)(p.x + (size_t)row * 2048 + col);
                const u32x2 ow = *(const u32x2*)((const bf16_t*)OUTF + (size_t)row * 2048 + col);
                const f32x4 ov = (f32x4){bflo(ow.x), bfhi(ow.x), bflo(ow.y), bfhi(ow.y)};
                const f32x4 nw = *(const f32x4*)(p.npost + col), gv = *(const f32x4*)(gl + col);
                f32x4 r;
#pragma unroll
                for (int k = 0; k < 4; ++k) r[k] = xv[k] + gv[k] * (ov[k] * rstd * nw[k]);
                *(f32x4*)(p.out + (size_t)row * 2048 + col) = r;
            }
        }
    }
}


#define XB_TMO      128
#define XB_XCNT(j)  (256  + 64 * (j))
#define XB_XSUB(j)  (1280 + 64 * (j))
#define XB_XGEN(j)  (2304 + 64 * (j))
#define XB_TOP      3328
#define XB_TOPGEN   3392
#define XCD_BAR_WORDS 3456
#define XB_SPIN_CAP (1u << 21)
__device__ __forceinline__ unsigned xb_ld(unsigned* p)              { return __hip_atomic_load(p, __ATOMIC_RELAXED, __HIP_MEMORY_SCOPE_AGENT); }
__device__ __forceinline__ unsigned xb_add(unsigned* p, unsigned v) { return __hip_atomic_fetch_add(p, v, __ATOMIC_RELAXED, __HIP_MEMORY_SCOPE_AGENT); }
__device__ __forceinline__ unsigned xb_xcc_id() { return (unsigned)__builtin_amdgcn_s_getreg((3 << 11) | 20) & 0xFu; }
#define XB_SPIN(cond, bar) do { unsigned _sp = 0; while (cond) { __builtin_amdgcn_s_sleep(1); \
    if ((++_sp & 255u) == 0u) { if (xb_ld(&(bar)[XB_TMO])) break; if (_sp > XB_SPIN_CAP) { atomicAdd(&(bar)[XB_TMO], 1u); break; } } } } while (0)
__device__ __forceinline__ void xcd_barrier_complete(unsigned* bar, unsigned x, unsigned& nloc, unsigned& nx) {
    const unsigned G = gridDim.x * gridDim.y * gridDim.z;
    unsigned sum, cnt, mine, sp = 0u;
    for (;;) {
        sum = 0u; cnt = 0u; mine = 0u;
#pragma unroll
        for (unsigned j = 0; j < 16; ++j) { const unsigned c = xb_ld(&bar[XB_XCNT(j)]); sum += c; cnt += (c > 0u) ? 1u : 0u; mine = (j == x) ? c : mine; }
        if (sum == G) break;
        __builtin_amdgcn_s_sleep(1);
        if ((++sp & 255u) == 0u) { if (xb_ld(&bar[XB_TMO])) break; if (sp > XB_SPIN_CAP) { atomicAdd(&bar[XB_TMO], 1u); break; } }
    }
    nloc = mine > 0u ? mine : 1u; nx = cnt > 0u ? cnt : 1u;
}
__device__ __forceinline__ void xcd_barrier(unsigned* bar, volatile LAS unsigned* st) {
    asm volatile("s_waitcnt vmcnt(0)" ::: "memory");
    __syncthreads();
    if (threadIdx.x == 0) {
        const unsigned x = xb_xcc_id();
        __builtin_amdgcn_s_waitcnt(0);
        unsigned nloc = st[0], nx = st[1];
        if (nloc == 0u) { xcd_barrier_complete(bar, x, nloc, nx); st[0] = nloc; st[1] = nx; }
        const unsigned old = xb_add(&bar[XB_XSUB(x)], 1u);
        const unsigned gen = old / nloc;
        if (old + 1u == (gen + 1u) * nloc) {
            __builtin_amdgcn_fence(__ATOMIC_RELEASE, "agent");
            asm volatile("s_waitcnt vmcnt(0)" ::: "memory");
            const unsigned og = xb_add(&bar[XB_TOP], 1u);
            const unsigned tg = og / nx;
            if (og + 1u == (tg + 1u) * nx) xb_add(&bar[XB_TOPGEN], 1u);
            else XB_SPIN(xb_ld(&bar[XB_TOPGEN]) == tg, bar);
            __builtin_amdgcn_fence(__ATOMIC_ACQUIRE, "agent");
            xb_add(&bar[XB_XGEN(x)], 1u);
            asm volatile("s_waitcnt vmcnt(0)" ::: "memory");
        } else {
            XB_SPIN(xb_ld(&bar[XB_XGEN(x)]) == gen, bar);
            __builtin_amdgcn_fence(__ATOMIC_ACQUIRE, "agent");
            asm volatile("s_waitcnt vmcnt(0)" ::: "memory");
        }
    }
    __syncthreads();
}

template <int PH>
__global__ void __launch_bounds__(512) mk_kernel(Params p) {
    extern __shared__ __attribute__((aligned(16))) unsigned char smem[];
    LAS unsigned char* lds = (LAS unsigned char*)smem;
    pg8::StaticOrder so;
    unsigned* bar = (unsigned*)(p.ws + OFF_BAR);
    volatile LAS unsigned* st = (volatile LAS unsigned*)(lds + LDS_MAIN);
    if (PH < 0) {
        if (threadIdx.x == 0) { st[0] = 0u; st[1] = 0u; }
        if (blockIdx.x == 0) { for (int i = threadIdx.x; i < XCD_BAR_WORDS; i += 512) __hip_atomic_store(&bar[i], 0u, __ATOMIC_RELAXED, __HIP_MEMORY_SCOPE_AGENT); }
        __syncthreads();
    }
#define SYNC() do { if (PH < 0) xcd_barrier((unsigned*)(p.ws + OFF_BAR), (volatile LAS unsigned*)(lds + LDS_MAIN)); } while (0)
    if (PH < 0 || PH == 0) phase0(p, smem);
    if (PH < 0) cg::this_grid().sync();
    if (PH < 0) { if (threadIdx.x == 0) (void)xb_add(&bar[XB_XCNT(xb_xcc_id())], 1u); }
    if (PH < 0 || PH == 1) phase1(p, smem);
    SYNC();
    if (PH < 0 || PH == 2) {
        pg8::Gemm g{(const bf16_t*)p.out, (const bf16_t*)(p.ws + OFF_WT1), 2048, T_, N1, 2048};
        so.init(T_, N1, gridDim.x, blockIdx.x);
        Epi1 e{(bf16_t*)(p.ws + OFF_P1), (bf16_t*)(p.ws + OFF_HB), (float*)(p.ws + OFF_SM)};
        pg8::gemm_phase(lds, g, so, e);
        { const int nfull = (T_ / 256) * (N1 / 256) - 12 * (int)gridDim.x;
          const int first = (nfull > 0 && nfull < (int)gridDim.x) ? nfull : 0;
          if ((int)blockIdx.x >= first) late_transposes(p, smem, (int)blockIdx.x - first, (int)gridDim.x - first); }
    }
    SYNC();
    if (PH < 0 || PH == 3) {
        for (int u = blockIdx.x * 2; u < 4096; u += gridDim.x * 2) prep_gdn(p, smem, u);
        for (int u = blockIdx.x * 2; u < 2048; u += gridDim.x * 2) prep_mlstm(p, smem, u);
    }
    SYNC();
    if (PH < 0 || PH == 4) {
        for (int u = blockIdx.x; u < 256; u += gridDim.x) {
            if (u < 128) { const int xcd = u & 7, kk = u >> 3, qg = xcd * 4 + (kk >> 2), wi = kk & 3;
                           const int bh = (qg >> 4) * 32 + (qg & 15) * 2 + (wi >> 1);
                           gdn_scan(p, smem, (bh << 1) | (wi & 1)); }
            else         { const int m = u - 128, xcd = m & 7, kk = m >> 3, stream = xcd * 2 + (kk >> 3);
                           mlstm_scan(p, smem, (stream << 3) | (kk & 7)); }
        }
    }
    SYNC();
    if (PH < 0 || PH == 5) {
        pg8::Gemm g{(const bf16_t*)p.out, (const bf16_t*)(p.ws + OFF_WT2), 2048, T_, N2, 2048};
        so.init(T_, N2, gridDim.x, blockIdx.x);
        Epi2 e{(bf16_t*)(p.ws + OFF_P1), (const float*)(p.ws + OFF_RSA), (const float*)(p.ws + OFF_RSB), p.gnw, p.mnw};
        pg8::gemm_phase(lds, g, so, e);
    }
    SYNC();
    if (PH < 0 || PH == 6) {
        so.init(T_, 2048, gridDim.x, blockIdx.x);
        { pg8::Gemm g{(const bf16_t*)(p.ws + OFF_P1) + 4096, (const bf16_t*)(p.ws + OFF_WTA), LDP, T_, 2048, 4096};
          EpiA e{(const bf16_t*)(p.ws + OFF_P1), p.out};
          pg8::gemm_phase(lds, g, so, e); }
        { pg8::Gemm g{(const bf16_t*)(p.ws + OFF_P1) + 10240, (const bf16_t*)(p.ws + OFF_WTB), LDP, T_, 2048, 2048};
          EpiB e{(bf16_t*)(p.ws + OFF_P1), p.out};
          pg8::gemm_phase(lds, g, so, e); }
    }
    SYNC();
    if (PH < 0 || PH == 7) {
        so.init(T_, 2048, gridDim.x, blockIdx.x);
        pg8::Gemm g{(const bf16_t*)(p.ws + OFF_P1) + 8192, (const bf16_t*)(p.ws + OFF_WTO), LDP, T_, 2048, 2048};
        EpiO e{(float*)(p.ws + OFF_WB), (float*)(p.ws + OFF_SSQ)};
        pg8::gemm_phase(lds, g, so, e);
    }
    SYNC();
    if (PH < 0 || PH == 8) phase_final(p, smem);
#undef SYNC
}

#ifndef MK_MULTI
#define MK_MULTI 0
#endif

template <int PH> static void launch_one(const Params& p, hipStream_t stream) {
    hipFuncSetAttribute((const void*)mk_kernel<PH>, hipFuncAttributeMaxDynamicSharedMemorySize, LDS_BYTES);
    hipLaunchKernelGGL(mk_kernel<PH>, dim3(256), dim3(512), LDS_BYTES, stream, p);
}

extern "C" void kernel_launch(void* const* d_in, const int* in_sizes, int n_in, void* d_out, int out_size, void* d_ws, size_t ws_size, hipStream_t stream) {
    Params p{};
    p.x = (const float*)d_in[0]; p.c = (const float*)d_in[1]; p.w_ada = (const float*)d_in[2]; p.b_ada = (const float*)d_in[3];
    p.npre = (const float*)d_in[4]; p.w_in = (const float*)d_in[5]; p.gconv = (const float*)d_in[6]; p.Alog = (const float*)d_in[7];
    p.dtb = (const float*)d_in[8]; p.gnw = (const float*)d_in[9]; p.mconv = (const float*)d_in[10]; p.mbi = (const float*)d_in[11];
    p.mbf = (const float*)d_in[12]; p.mnw = (const float*)d_in[13]; p.wpa = (const float*)d_in[14]; p.wpb = (const float*)d_in[15];
    p.wout = (const float*)d_in[16]; p.npost = (const float*)d_in[17];
    p.out = (float*)d_out; p.ws = (unsigned char*)d_ws;
    if (ws_size < WS_NEED) { fprintf(stderr, "workspace too small: %zu < %zu\n", ws_size, (size_t)WS_NEED); return; }
#if MK_MULTI
    launch_one<0>(p, stream); launch_one<1>(p, stream); launch_one<2>(p, stream); launch_one<3>(p, stream); launch_one<4>(p, stream);
    launch_one<5>(p, stream); launch_one<6>(p, stream); launch_one<7>(p, stream); launch_one<8>(p, stream);
#else
    static int grid_blocks = 0;
    if (!grid_blocks) {
        int dev = 0, cus = 0, per_cu = 0;
        hipGetDevice(&dev);
        hipDeviceGetAttribute(&cus, hipDeviceAttributeMultiprocessorCount, dev);
        hipFuncSetAttribute((const void*)mk_kernel<-1>, hipFuncAttributeMaxDynamicSharedMemorySize, LDS_BYTES);
        hipOccupancyMaxActiveBlocksPerMultiprocessor(&per_cu, mk_kernel<-1>, 512, LDS_BYTES);
        grid_blocks = cus * per_cu;
        if (grid_blocks > 256) grid_blocks = 256;
    }
    void* args[] = {&p};
    hipError_t e = hipLaunchCooperativeKernel((void*)mk_kernel<-1>, dim3(grid_blocks), dim3(512), args, LDS_BYTES, stream);
    if (e != hipSuccess) fprintf(stderr, "cooperative launch failed: %s (grid %d)\n", hipGetErrorString(e), grid_blocks);
#endif
}
```

```cpp
#include <hip/hip_runtime.h>
#include <hip/hip_cooperative_groups.h>
#include <cstdio>
namespace cg = cooperative_groups;

#define LAS __attribute__((address_space(3)))
typedef unsigned short bf16_t;
typedef short bf16x8 __attribute__((ext_vector_type(8)));
typedef float f32x4 __attribute__((ext_vector_type(4)));
typedef float f32x2 __attribute__((ext_vector_type(2)));
typedef unsigned u32x4 __attribute__((ext_vector_type(4)));
typedef unsigned u32x2 __attribute__((ext_vector_type(2)));

constexpr int T_ = 16384, SEQ_ = 8192;
constexpr int LDP = 12288;
constexpr int N1 = 12544, N2 = 12288, INW = 24656;
constexpr int LDS_MAIN = 142336;
constexpr int LDS_BYTES = LDS_MAIN + 256;
constexpr float EPS = 1e-6f;

constexpr size_t OFF_WT1 = 0;
constexpr size_t OFF_WT2 = OFF_WT1 + (size_t)N1 * 2048 * 2;
constexpr size_t OFF_WTA = OFF_WT2 + (size_t)N2 * 2048 * 2;
constexpr size_t OFF_WTB = OFF_WTA + (size_t)2048 * 4096 * 2;
constexpr size_t OFF_WTO = OFF_WTB + (size_t)2048 * 2048 * 2;
constexpr size_t OFF_P1 = OFF_WTO + (size_t)2048 * 2048 * 2;
constexpr size_t OFF_SM = OFF_P1 + (size_t)T_ * LDP * 2;
constexpr size_t OFF_HB = OFF_SM + (size_t)T_ * 80 * 4;
constexpr size_t OFF_WB = OFF_HB + (size_t)2 * 128 * 3 * 10240 * 2;
constexpr size_t OFF_GC = OFF_WB + (size_t)T_ * 4096 * 2;
constexpr size_t OFF_MODP = OFF_GC + (size_t)T_ * 32 * 4;
constexpr size_t OFF_RSA = OFF_MODP + (size_t)8 * 2 * 6144 * 4;
constexpr size_t OFF_RSB = OFF_RSA + (size_t)T_ * 32 * 2 * 4;
constexpr size_t OFF_SSQ = OFF_RSB + (size_t)T_ * 8 * 8 * 4;
constexpr size_t OFF_BAR = OFF_SSQ + (size_t)T_ * 32 * 4;
constexpr size_t WS_NEED = OFF_BAR + 16384;

struct Params {
    const float *x, *c, *w_ada, *b_ada, *npre, *w_in, *gconv, *Alog, *dtb, *gnw, *mconv, *mbi, *mbf, *mnw, *wpa, *wpb, *wout, *npost;
    float* out;
    unsigned char* ws;
};

typedef __bf16 bf16v2_t __attribute__((ext_vector_type(2)));
__device__ __forceinline__ unsigned cvt_pk_bf16(float lo, float hi) { bf16v2_t v; v.x = (__bf16)lo; v.y = (__bf16)hi; return __builtin_bit_cast(unsigned, v); }
__device__ __forceinline__ bf16_t f2bf(float f) { return (bf16_t)(cvt_pk_bf16(f, 0.f) & 0xffffu); }
__device__ __forceinline__ float bf2f(bf16_t v) { return __uint_as_float(((unsigned)v) << 16); }
__device__ __forceinline__ float bflo(unsigned w) { return __uint_as_float(w << 16); }
__device__ __forceinline__ float bfhi(unsigned w) { return __uint_as_float(w & 0xffff0000u); }
__device__ __forceinline__ float sigmoidf_(float x) { return __builtin_amdgcn_rcpf(1.0f + __expf(-x)); }
__device__ __forceinline__ float siluf_(float x) { return x * __builtin_amdgcn_rcpf(1.0f + __expf(-x)); }
__device__ __forceinline__ f32x4 mfma16(bf16x8 a, bf16x8 b, f32x4 c) { return __builtin_amdgcn_mfma_f32_16x16x32_bf16(a, b, c, 0, 0, 0); }
__device__ __forceinline__ void unpack8(const u32x4 v, float (&f)[8]) {
    f[0] = bflo(v.x); f[1] = bfhi(v.x); f[2] = bflo(v.y); f[3] = bfhi(v.y); f[4] = bflo(v.z); f[5] = bfhi(v.z); f[6] = bflo(v.w); f[7] = bfhi(v.w);
}
__device__ __forceinline__ u32x4 pack8(const float (&f)[8]) {
    u32x4 w; w.x = cvt_pk_bf16(f[0], f[1]); w.y = cvt_pk_bf16(f[2], f[3]); w.z = cvt_pk_bf16(f[4], f[5]); w.w = cvt_pk_bf16(f[6], f[7]); return w;
}
__device__ __forceinline__ u32x2 pack4(float a, float b, float c, float d) { u32x2 w; w.x = cvt_pk_bf16(a, b); w.y = cvt_pk_bf16(c, d); return w; }
__device__ __forceinline__ float wave_scan_add(float v, int lane) {
#pragma unroll
    for (int d = 1; d < 64; d <<= 1) { float t = __shfl_up(v, d); if (lane >= d) v += t; }
    return v;
}
__device__ __forceinline__ float wave_scan_max(float v, int lane) {
#pragma unroll
    for (int d = 1; d < 64; d <<= 1) { float t = __shfl_up(v, d); if (lane >= d) v = fmaxf(v, t); }
    return v;
}
__device__ __forceinline__ float wave_sum(float v) {
#pragma unroll
    for (int d = 32; d >= 1; d >>= 1) v += __shfl_xor(v, d);
    return v;
}

namespace pg8 {
constexpr int BM = 256, BK = 64, HALF = 128, HTB = HALF * BK * 2, STAGE_BYTES = 8 * HTB, NXCD = 8, WGM = 4;
__host__ __device__ __forceinline__ int lds_byte(int r, int c) { const int st = (r >> 4) * 2 + (c >> 5), rr = r & 15, cc = c & 31, ob = rr * 64 + cc * 2; return st * 1024 + (ob ^ (((ob >> 9) & 1) << 5)); }
__host__ __device__ __forceinline__ void stage_rc(int b, int& R, int& C) { const int st = b / 1024, sb = b % 1024, swz = sb ^ (((sb >> 9) & 1) << 5); R = (st >> 1) * 16 + swz / 64; C = (st & 1) * 32 + (swz % 64) / 2; }
__host__ __device__ __forceinline__ int perm32(int rho) { const int n = rho >> 4, i = rho & 15; return 8 * (i >> 2) + 4 * n + (i & 3); }
struct Unit { int pm, pn; };
struct Gemm { const bf16_t* A; const bf16_t* Bt; int lda; int M, N, K; };
struct StaticOrder {
    int nM, nN, nwg, G, c;
    __device__ void init(int M, int N, int G_, int c_) { nM = M / BM; nN = N / BM; nwg = nM * nN; G = G_; c = c_; }
    __device__ bool next(int i, Unit& u) const {
        const long L = (long)i * G + c; if (L >= nwg) return false;
        int wgid = (int)L; { const int q = nwg / NXCD, r = nwg % NXCD, xcd = wgid % NXCD, off = wgid / NXCD; wgid = (xcd < r ? xcd * (q + 1) : r * (q + 1) + (xcd - r) * q) + off; }
        const int nig = WGM * nN, gid = wgid / nig, fm = gid * WGM, gsz = (nM - fm) < WGM ? (nM - fm) : WGM;
        u.pm = fm + ((wgid % nig) % gsz); u.pn = (wgid % nig) / gsz; return true;
    }
};
template <class Epi>
__device__ __forceinline__ void gemm_phase(LAS unsigned char* lds, const Gemm g, const StaticOrder& S, const Epi& E) {
    int tid_ = threadIdx.x; asm volatile("" : "+v"(tid_));
    const int tid = tid_, wid = __builtin_amdgcn_readfirstlane(tid >> 6), lane = tid & 63, wr = wid >> 2, wc = wid & 3, fr = lane & 15, fq = lane >> 4;
    const int K = g.K, nt = K / BK;
    unsigned voffA[2], voffB[2];
#pragma unroll
    for (int i = 0; i < 2; ++i) { int R, C; stage_rc(tid * 16 + i * 8192, R, C); const int Rb = (R & ~31) + perm32(R & 31);
        voffA[i] = (unsigned)(R * g.lda + C) * 2u; voffB[i] = (unsigned)(Rb * K + C) * 2u; }
    const size_t kstep = (size_t)(BK * 2);
    const size_t hstepA = (size_t)HALF * g.lda * 2, tstepA = 2 * hstepA;
    const size_t hstepB = (size_t)HALF * K * 2, tstepB = 2 * hstepB;
    const unsigned ldsw = (unsigned)wid * 1024u;
    const int aoff = lds_byte(wr * 64 + fr, fq * 8), boff = lds_byte(wc * 32 + fr, fq * 8);
#define PG8_SA(b, h) (((b) * 2 + (h)) * HTB)
#define PG8_SB(b, h) ((4 + (b) * 2 + (h)) * HTB)
#define PG8_STAGE(bufoff, gbase, voff) do { _Pragma("unroll") for (int _i = 0; _i < 2; ++_i) \
        __builtin_amdgcn_global_load_lds((const unsigned*)((const char*)(gbase) + (voff)[_i]), (LAS unsigned*)(lds + (bufoff) + ldsw + _i * 8192), 16, 0, 0); } while (0)
#define PG8_LDA(dst, b, h) do { _Pragma("unroll") for (int m = 0; m < 4; ++m) _Pragma("unroll") for (int k = 0; k < 2; ++k) dst[m][k] = *(const LAS bf16x8*)(lds + PG8_SA(b, h) + aoff + m * 2048 + k * 1024); } while (0)
#define PG8_LDB(dst, b, h) do { _Pragma("unroll") for (int n = 0; n < 2; ++n) _Pragma("unroll") for (int k = 0; k < 2; ++k) dst[n][k] = *(const LAS bf16x8*)(lds + PG8_SB(b, h) + boff + n * 2048 + k * 1024); } while (0)
#define PG8_MMA(ai, bj, At, Bt) do { __builtin_amdgcn_s_setprio(1); _Pragma("unroll") for (int m = 0; m < 4; ++m) _Pragma("unroll") for (int n = 0; n < 2; ++n) _Pragma("unroll") for (int k = 0; k < 2; ++k) \
        acc[ai][bj][m][n] = __builtin_amdgcn_mfma_f32_16x16x32_bf16(Bt[n][k], At[m][k], acc[ai][bj][m][n], 0, 0, 0); __builtin_amdgcn_s_setprio(0); } while (0)
#define PG8_WAIT_V(n) asm volatile("s_waitcnt vmcnt(" #n ")" ::: "memory")
#define PG8_WAIT_L(n) asm volatile("s_waitcnt lgkmcnt(" #n ")" ::: "memory")
#define PG8_BAR __builtin_amdgcn_s_barrier()
#define PG8_SCHED __builtin_amdgcn_sched_barrier(0)
    Unit cur, nxt; int ui = 0;
    if (!S.next(0, cur)) return;
    f32x4 acc[2][2][4][2];
#pragma unroll
    for (int a = 0; a < 2; ++a)
#pragma unroll
        for (int b = 0; b < 2; ++b)
#pragma unroll
            for (int m = 0; m < 4; ++m)
#pragma unroll
                for (int n = 0; n < 2; ++n) acc[a][b][m][n] = (f32x4){0.f, 0.f, 0.f, 0.f};
    bf16x8 At[4][2], B0[2][2], B1[2][2];
    const char* cA = (const char*)g.A + (size_t)cur.pm * tstepA; const char* cB = (const char*)g.Bt + (size_t)cur.pn * tstepB;
    PG8_STAGE(PG8_SB(0, 0), cB, voffB); PG8_STAGE(PG8_SA(0, 0), cA, voffA); PG8_STAGE(PG8_SB(0, 1), cB + hstepB, voffB); PG8_STAGE(PG8_SA(0, 1), cA + hstepA, voffA);
    if (wr == 1) PG8_BAR;
    PG8_WAIT_V(4); PG8_BAR;
    PG8_STAGE(PG8_SB(1, 0), cB + kstep, voffB); PG8_STAGE(PG8_SA(1, 0), cA + kstep, voffA); PG8_STAGE(PG8_SB(1, 1), cB + hstepB + kstep, voffB);
    PG8_WAIT_V(6); PG8_BAR;
    for (;;) {
        const bool has_next = S.next(ui + 1, nxt);
        const char* nA = has_next ? (const char*)g.A + (size_t)nxt.pm * tstepA : cA; const char* nB = has_next ? (const char*)g.Bt + (size_t)nxt.pn * tstepB : cB;
        for (int t = 0; t < nt; t += 2) {
            const bool last = (t == nt - 2);
            const char* a1 = cA + (size_t)(t + 1) * kstep;
            const char* a2 = last ? nA : cA + (size_t)(t + 2) * kstep; const char* b2 = last ? nB : cB + (size_t)(t + 2) * kstep;
            const char* a3 = a2 + kstep; const char* b3 = b2 + kstep;
            PG8_LDB(B0, 0, 0); PG8_SCHED; PG8_LDA(At, 0, 0); PG8_STAGE(PG8_SA(1, 1), a1 + hstepA, voffA);
            PG8_WAIT_L(8); PG8_BAR; PG8_WAIT_L(0); PG8_MMA(0, 0, At, B0); PG8_BAR; PG8_SCHED;
            PG8_LDB(B1, 0, 1); PG8_STAGE(PG8_SB(0, 0), b2, voffB);
            PG8_BAR; PG8_WAIT_L(0); PG8_MMA(0, 1, At, B1); PG8_BAR;
            PG8_LDA(At, 0, 1); PG8_STAGE(PG8_SA(0, 0), a2, voffA);
            PG8_BAR; PG8_WAIT_L(0); PG8_MMA(1, 0, At, B0); PG8_BAR; PG8_SCHED;
            PG8_STAGE(PG8_SB(0, 1), b2 + hstepB, voffB);
            PG8_WAIT_V(6); PG8_BAR; PG8_MMA(1, 1, At, B1); PG8_BAR;
            PG8_LDB(B0, 1, 0); PG8_SCHED; PG8_LDA(At, 1, 0); PG8_STAGE(PG8_SA(0, 1), a2 + hstepA, voffA);
            PG8_WAIT_L(8); PG8_BAR; PG8_WAIT_L(0); PG8_MMA(0, 0, At, B0); PG8_BAR; PG8_SCHED;
            PG8_LDB(B1, 1, 1); PG8_STAGE(PG8_SB(1, 0), b3, voffB);
            PG8_BAR; PG8_WAIT_L(0); PG8_MMA(0, 1, At, B1); PG8_BAR;
            PG8_LDA(At, 1, 1); PG8_STAGE(PG8_SA(1, 0), a3, voffA);
            PG8_BAR; PG8_WAIT_L(0); PG8_MMA(1, 0, At, B0); PG8_BAR; PG8_SCHED;
            PG8_STAGE(PG8_SB(1, 1), b3 + hstepB, voffB);
            PG8_WAIT_V(6); PG8_BAR; PG8_MMA(1, 1, At, B1); PG8_BAR;
        }
        E(acc, cur, wr, wc, fr, fq);
        if (!has_next) break;
#pragma unroll
        for (int a = 0; a < 2; ++a)
#pragma unroll
            for (int b = 0; b < 2; ++b)
#pragma unroll
                for (int m = 0; m < 4; ++m)
#pragma unroll
                    for (int n = 0; n < 2; ++n) acc[a][b][m][n] = (f32x4){0.f, 0.f, 0.f, 0.f};
        cur = nxt; cA = nA; cB = nB; ++ui;
    }
    PG8_WAIT_V(0);
    if (wr == 0) PG8_BAR;
    PG8_BAR;
#undef PG8_SA
#undef PG8_SB
#undef PG8_STAGE
#undef PG8_LDA
#undef PG8_LDB
#undef PG8_MMA
#undef PG8_WAIT_V
#undef PG8_WAIT_L
#undef PG8_BAR
#undef PG8_SCHED
}
}

typedef f32x4 AccT[2][2][4][2];

struct Epi1 {
    bf16_t* P1; bf16_t* HB; float* SM;
    __device__ __forceinline__ void operator()(const AccT& acc, const pg8::Unit& u, int wr, int wc, int fr, int fq) const {
        if (u.pn < 48) {
#pragma unroll
            for (int ai = 0; ai < 2; ++ai)
#pragma unroll
                for (int m = 0; m < 4; ++m) {
                    const int row = u.pm * 256 + ai * 128 + wr * 64 + m * 16 + fr;
#pragma unroll
                    for (int bj = 0; bj < 2; ++bj) {
                        const int col = u.pn * 256 + bj * 128 + wc * 32 + 8 * fq;
                        const f32x4 v0 = acc[ai][bj][m][0], v1 = acc[ai][bj][m][1];
                        u32x4 w; w.x = cvt_pk_bf16(v0[0], v0[1]); w.y = cvt_pk_bf16(v0[2], v0[3]); w.z = cvt_pk_bf16(v1[0], v1[1]); w.w = cvt_pk_bf16(v1[2], v1[3]);
                        *(u32x4*)(P1 + (size_t)row * LDP + col) = w;
                        if (m == 3 && fr >= 13 && u.pn < 40) {
                            const int b = row >> 13, ch = (row & 8191) >> 6;
                            *(u32x4*)(HB + ((size_t)(b * 128 + ch) * 3 + (fr - 13)) * 10240 + col) = w;
                        }
                    }
                }
        } else {
#pragma unroll
            for (int ai = 0; ai < 2; ++ai)
#pragma unroll
                for (int m = 0; m < 4; ++m) {
                    const int row = u.pm * 256 + ai * 128 + wr * 64 + m * 16 + fr;
#pragma unroll
                    for (int bj = 0; bj < 2; ++bj) {
                        const int lc = bj * 128 + wc * 32 + 8 * fq;
                        if (lc < 80) {
#pragma unroll
                            for (int e = 0; e < 4; ++e) { SM[(size_t)(lc + e) * T_ + row] = acc[ai][bj][m][0][e]; SM[(size_t)(lc + 4 + e) * T_ + row] = acc[ai][bj][m][1][e]; }
                        }
                    }
                }
        }
    }
};

struct Epi2 {
    bf16_t* P1; const float* RSA; const float* RSB; const float* gnw; const float* mnw;
    __device__ __forceinline__ void operator()(const AccT& acc, const pg8::Unit& u, int wr, int wc, int fr, int fq) const {
        if (u.pn < 16) {
            f32x4 nwv[2][2];
#pragma unroll
            for (int bj = 0; bj < 2; ++bj) { const int ch = (bj * 128 + wc * 32 + 8 * fq) & 127; nwv[bj][0] = *(const f32x4*)(gnw + ch); nwv[bj][1] = *(const f32x4*)(gnw + ch + 4); }
#pragma unroll
            for (int ai = 0; ai < 2; ++ai) {
                u32x4 ov[4][2]; f32x2 pp[4][2];
#pragma unroll
                for (int m = 0; m < 4; ++m)
#pragma unroll
                    for (int bj = 0; bj < 2; ++bj) {
                        const int row = u.pm * 256 + ai * 128 + wr * 64 + m * 16 + fr;
                        const int gc = u.pn * 256 + bj * 128 + wc * 32 + 8 * fq, head = gc >> 7;
                        ov[m][bj] = *(const u32x4*)(P1 + (size_t)row * LDP + 4096 + gc);
                        { const int bb_ = row >> 13, ts_ = row & 8191; pp[m][bj].x = RSA[(size_t)((bb_ * 32 + head) * 2) * SEQ_ + ts_]; pp[m][bj].y = RSA[(size_t)((bb_ * 32 + head) * 2 + 1) * SEQ_ + ts_]; }
                    }
#pragma unroll
                for (int m = 0; m < 4; ++m)
#pragma unroll
                    for (int bj = 0; bj < 2; ++bj) {
                        const int row = u.pm * 256 + ai * 128 + wr * 64 + m * 16 + fr;
                        const int gc = u.pn * 256 + bj * 128 + wc * 32 + 8 * fq;
                        const float rstd = rsqrtf((pp[m][bj].x + pp[m][bj].y) * (1.0f / 128.0f) + EPS);
                        float o[8]; unpack8(ov[m][bj], o);
                        const f32x4 z0 = acc[ai][bj][m][0], z1 = acc[ai][bj][m][1];
                        float r[8];
#pragma unroll
                        for (int e = 0; e < 4; ++e) { r[e] = o[e] * rstd * nwv[bj][0][e] * siluf_(z0[e]); r[4 + e] = o[4 + e] * rstd * nwv[bj][1][e] * siluf_(z1[e]); }
                        *(u32x4*)(P1 + (size_t)row * LDP + 4096 + gc) = pack8(r);
                    }
                asm volatile("" ::: "memory");
            }
        } else if (u.pn < 32) {
            const int q = u.pn - 16;
            const int cc = q * 128 + wc * 32 + 8 * fq, head = cc >> 8;
            const f32x4 nw0 = *(const f32x4*)(mnw + cc), nw1 = *(const f32x4*)(mnw + cc + 4);
#pragma unroll
            for (int ai = 0; ai < 2; ++ai) {
                u32x4 ov[4]; f32x4 p0[4], p1[4];
#pragma unroll
                for (int m = 0; m < 4; ++m) {
                    const int row = u.pm * 256 + ai * 128 + wr * 64 + m * 16 + fr;
                    ov[m] = *(const u32x4*)(P1 + (size_t)row * LDP + 10240 + cc);
                    { const int bb_ = row >> 13, ts_ = row & 8191; const float* rb_ = RSB + (size_t)((bb_ * 8 + head) * 8) * SEQ_ + ts_;
#pragma unroll
                      for (int k_ = 0; k_ < 4; ++k_) { p0[m][k_] = rb_[(size_t)k_ * SEQ_]; p1[m][k_] = rb_[(size_t)(4 + k_) * SEQ_]; } }
                }
#pragma unroll
                for (int m = 0; m < 4; ++m) {
                    const int row = u.pm * 256 + ai * 128 + wr * 64 + m * 16 + fr;
                    const float ss = (p0[m][0] + p0[m][1]) + (p0[m][2] + p0[m][3]) + (p1[m][0] + p1[m][1]) + (p1[m][2] + p1[m][3]);
                    const float rstd = rsqrtf(ss * (1.0f / 256.0f) + EPS);
                    float o[8]; unpack8(ov[m], o);
                    const f32x4 g0 = acc[ai][0][m][0], g1 = acc[ai][0][m][1], z0 = acc[ai][1][m][0], z1 = acc[ai][1][m][1];
                    float r[8];
#pragma unroll
                    for (int e = 0; e < 4; ++e) { r[e] = sigmoidf_(g0[e]) * o[e] * rstd * nw0[e] * siluf_(z0[e]); r[4 + e] = sigmoidf_(g1[e]) * o[4 + e] * rstd * nw1[e] * siluf_(z1[e]); }
                    *(u32x4*)(P1 + (size_t)row * LDP + 10240 + cc) = pack8(r);
                }
                asm volatile("" ::: "memory");
            }
        } else {
#pragma unroll
            for (int ai = 0; ai < 2; ++ai)
#pragma unroll
                for (int m = 0; m < 4; ++m) {
                    const int row = u.pm * 256 + ai * 128 + wr * 64 + m * 16 + fr;
#pragma unroll
                    for (int bj = 0; bj < 2; ++bj) {
                        const int col = (u.pn - 32) * 256 + bj * 128 + wc * 32 + 8 * fq;
                        const f32x4 v0 = acc[ai][bj][m][0], v1 = acc[ai][bj][m][1];
                        float r[8];
#pragma unroll
                        for (int e = 0; e < 4; ++e) { r[e] = sigmoidf_(v0[e]); r[4 + e] = sigmoidf_(v1[e]); }
                        *(u32x4*)(P1 + (size_t)row * LDP + col) = pack8(r);
                    }
                }
        }
    }
};

struct EpiA {
    const bf16_t* P1; float* tmp;
    __device__ __forceinline__ void operator()(const AccT& acc, const pg8::Unit& u, int wr, int wc, int fr, int fq) const {
#pragma unroll
        for (int ai = 0; ai < 2; ++ai) {
            u32x4 sv[4][2];
#pragma unroll
            for (int m = 0; m < 4; ++m)
#pragma unroll
                for (int bj = 0; bj < 2; ++bj) {
                    const int row = u.pm * 256 + ai * 128 + wr * 64 + m * 16 + fr, col = u.pn * 256 + bj * 128 + wc * 32 + 8 * fq;
                    sv[m][bj] = *(const u32x4*)(P1 + (size_t)row * LDP + col);
                }
#pragma unroll
            for (int m = 0; m < 4; ++m)
#pragma unroll
                for (int bj = 0; bj < 2; ++bj) {
                    const int row = u.pm * 256 + ai * 128 + wr * 64 + m * 16 + fr, col = u.pn * 256 + bj * 128 + wc * 32 + 8 * fq;
                    float s[8]; unpack8(sv[m][bj], s);
                    const f32x4 v0 = acc[ai][bj][m][0], v1 = acc[ai][bj][m][1];
                    float r[8];
#pragma unroll
                    for (int e = 0; e < 4; ++e) { r[e] = s[e] * v0[e]; r[4 + e] = s[4 + e] * v1[e]; }
                    *(u32x4*)((bf16_t*)tmp + (size_t)row * 2048 + col) = pack8(r);
                }
            asm volatile("" ::: "memory");
        }
    }
};
struct EpiB {
    bf16_t* P1; const float* tmp;
    __device__ __forceinline__ void operator()(const AccT& acc, const pg8::Unit& u, int wr, int wc, int fr, int fq) const {
#pragma unroll
        for (int ai = 0; ai < 2; ++ai)
#pragma unroll
            for (int mh = 0; mh < 2; ++mh) {
                u32x4 sv[2][2], tv[2][2];
#pragma unroll
                for (int mm = 0; mm < 2; ++mm)
#pragma unroll
                    for (int bj = 0; bj < 2; ++bj) {
                        const int m = mh * 2 + mm;
                        const int row = u.pm * 256 + ai * 128 + wr * 64 + m * 16 + fr, col = u.pn * 256 + bj * 128 + wc * 32 + 8 * fq;
                        sv[mm][bj] = *(const u32x4*)(P1 + (size_t)row * LDP + 2048 + col);
                        tv[mm][bj] = *(const u32x4*)((const bf16_t*)tmp + (size_t)row * 2048 + col);
                    }
#pragma unroll
                for (int mm = 0; mm < 2; ++mm)
#pragma unroll
                    for (int bj = 0; bj < 2; ++bj) {
                        const int m = mh * 2 + mm;
                        const int row = u.pm * 256 + ai * 128 + wr * 64 + m * 16 + fr, col = u.pn * 256 + bj * 128 + wc * 32 + 8 * fq;
                        float s[8], t[8]; unpack8(sv[mm][bj], s); unpack8(tv[mm][bj], t);
                        const f32x4 v0 = acc[ai][bj][m][0], v1 = acc[ai][bj][m][1];
                        float r[8];
#pragma unroll
                        for (int e = 0; e < 4; ++e) { r[e] = t[e] + s[e] * v0[e]; r[4 + e] = t[4 + e] + s[4 + e] * v1[e]; }
                        *(u32x4*)(P1 + (size_t)row * LDP + 8192 + col) = pack8(r);
                    }
                asm volatile("" ::: "memory");
            }
    }
};
struct EpiO {
    float* OUTF; float* SSQ;
    __device__ __forceinline__ void operator()(const AccT& acc, const pg8::Unit& u, int wr, int wc, int fr, int fq) const {
#pragma unroll
        for (int ai = 0; ai < 2; ++ai)
#pragma unroll
            for (int m = 0; m < 4; ++m) {
                const int row = u.pm * 256 + ai * 128 + wr * 64 + m * 16 + fr;
                float s = 0.f;
#pragma unroll
                for (int bj = 0; bj < 2; ++bj) {
                    const int col = u.pn * 256 + bj * 128 + wc * 32 + 8 * fq;
                    const f32x4 v0 = acc[ai][bj][m][0], v1 = acc[ai][bj][m][1];
                    u32x4 wv; wv.x = cvt_pk_bf16(v0[0], v0[1]); wv.y = cvt_pk_bf16(v0[2], v0[3]); wv.z = cvt_pk_bf16(v1[0], v1[1]); wv.w = cvt_pk_bf16(v1[2], v1[3]);
                    *(u32x4*)((bf16_t*)OUTF + (size_t)row * 2048 + col) = wv;
#pragma unroll
                    for (int e = 0; e < 4; ++e) s += v0[e] * v0[e] + v1[e] * v1[e];
                }
                s += __shfl_xor(s, 16); s += __shfl_xor(s, 32);
                if (fq == 0) SSQ[(size_t)row * 32 + u.pn * 4 + wc] = s;
            }
    }
};

__device__ __forceinline__ int orig1(int n) {
    if (n < 8192) return n;
    if (n < 10240) return 12352 + (n - 8192);
    if (n < 12288) return 14400 + (n - 10240);
    const int j = n - 12288;
    if (j < 64) return 8192 + j;
    if (j < 80) return 16448 + (j - 64);
    return -1;
}
__device__ __forceinline__ int orig2(int n) {
    if (n < 4096) return 8256 + n;
    if (n < 8192) { const int q = (n - 4096) >> 8, l = (n - 4096) & 255; return l < 128 ? 16464 + 128 * q + l : 18512 + 128 * q + (l - 128); }
    if (n < 10240) return 20560 + (n - 8192);
    return 22608 + (n - 10240);
}
__device__ void transpose_tile(const float* __restrict__ W, int ldw, int K, bf16_t* __restrict__ Wt, int n0, int k0, int which, float* tl) {
    const int tid = threadIdx.x;
    const int nn = (tid & 31) * 4, n = n0 + nn;
    const int oc = which == 1 ? orig1(n) : (which == 2 ? orig2(n) : n);
    f32x4 v[8];
#pragma unroll
    for (int pass = 0; pass < 8; ++pass) {
        const int kk = (tid >> 5) + 16 * pass;
        v[pass] = (f32x4){0.f, 0.f, 0.f, 0.f};
        if (oc >= 0) v[pass] = *(const f32x4*)(W + (size_t)(k0 + kk) * ldw + oc);
    }
#pragma unroll
    for (int pass = 0; pass < 8; ++pass) {
        const int kk = (tid >> 5) + 16 * pass;
        tl[kk * 129 + nn] = v[pass][0]; tl[kk * 129 + nn + 1] = v[pass][1]; tl[kk * 129 + nn + 2] = v[pass][2]; tl[kk * 129 + nn + 3] = v[pass][3];
    }
    __syncthreads();
#pragma unroll
    for (int r = 0; r < 4; ++r) {
        const int pce = tid + 512 * r, nl = pce >> 4, kg = pce & 15;
        float f[8];
#pragma unroll
        for (int e = 0; e < 8; ++e) f[e] = tl[(kg * 8 + e) * 129 + nl];
        *(u32x4*)(Wt + (size_t)(n0 + nl) * K + k0 + kg * 8) = pack8(f);
    }
    __syncthreads();
}

__device__ void phase0(const Params& p, unsigned char* smem) {
    float* tl = (float*)smem;
    int tid_ = threadIdx.x; asm volatile("" : "+v"(tid_));
    const int tid = tid_;
    bf16_t* WT1 = (bf16_t*)(p.ws + OFF_WT1); bf16_t* WT2 = (bf16_t*)(p.ws + OFF_WT2);
    bf16_t* WTA = (bf16_t*)(p.ws + OFF_WTA); bf16_t* WTB = (bf16_t*)(p.ws + OFF_WTB); bf16_t* WTO = (bf16_t*)(p.ws + OFF_WTO);
    float* MODP = (float*)(p.ws + OFF_MODP);
    constexpr int NT1 = (N1 / 128) * 16, NT2 = (N2 / 128) * 16, NTA = 16 * 32, NTB = 16 * 16, NTO = 16 * 16, NADA = 192;
    constexpr int NU = NADA + NT1;
    for (int u = blockIdx.x; u < NU; u += gridDim.x) {
        if (u < NADA) {
            const int cb = u % 24, ks = u / 24;
            float* sl = tl;
            float* red = tl + 512;
            __syncthreads();
            { const int bb = tid >> 8, kk = tid & 255; sl[tid] = siluf_(p.c[bb * 2048 + ks * 256 + kk]); }
            __syncthreads();
            const int col = cb * 256 + (tid & 255), half = tid >> 8;
            float a0 = 0.f, a1 = 0.f;
            const float* wp = p.w_ada + (size_t)(ks * 256 + half * 128) * 6144 + col;
#pragma unroll 8
            for (int i = 0; i < 128; ++i) { const float w = wp[(size_t)i * 6144]; a0 += sl[half * 128 + i] * w; a1 += sl[256 + half * 128 + i] * w; }
            if (half == 1) { red[tid & 255] = a0; red[256 + (tid & 255)] = a1; }
            __syncthreads();
            if (half == 0) { MODP[(ks * 2 + 0) * 6144 + col] = a0 + red[tid]; MODP[(ks * 2 + 1) * 6144 + col] = a1 + red[256 + tid]; }
            __syncthreads();
        } else {
            int t = u - NADA;
            transpose_tile(p.w_in, INW, 2048, WT1, (t >> 4) * 128, (t & 15) * 128, 1, tl);
        }
    }
    (void)WT2; (void)WTA; (void)WTB; (void)WTO; (void)NT2; (void)NTA; (void)NTB; (void)NTO;
}

__device__ void late_transposes(const Params& p, unsigned char* smem, int idx, int nblk) {
    float* tl = (float*)smem;
    bf16_t* WT2 = (bf16_t*)(p.ws + OFF_WT2);
    bf16_t* WTA = (bf16_t*)(p.ws + OFF_WTA); bf16_t* WTB = (bf16_t*)(p.ws + OFF_WTB); bf16_t* WTO = (bf16_t*)(p.ws + OFF_WTO);
    constexpr int NT2 = (N2 / 128) * 16, NTA = 16 * 32, NTB = 16 * 16, NTO = 16 * 16;
    __syncthreads();
    for (int u = idx; u < NT2 + NTA + NTB + NTO; u += nblk) {
        int t = u;
        if (t < NT2) { transpose_tile(p.w_in, INW, 2048, WT2, (t >> 4) * 128, (t & 15) * 128, 2, tl); continue; }
        t -= NT2;
        if (t < NTA) { transpose_tile(p.wpa, 2048, 4096, WTA, (t >> 5) * 128, (t & 31) * 128, 0, tl); continue; }
        t -= NTA;
        if (t < NTB) { transpose_tile(p.wpb, 2048, 2048, WTB, (t >> 4) * 128, (t & 15) * 128, 0, tl); continue; }
        t -= NTB;
        transpose_tile(p.wout, 2048, 2048, WTO, (t >> 4) * 128, (t & 15) * 128, 0, tl);
    }
}

__device__ void phase1(const Params& p, unsigned char* smem) {
    float* shl = (float*)smem;
    float* scl = shl + 2048;
    const float* MODP = (const float*)(p.ws + OFF_MODP);
    bf16_t* H = (bf16_t*)p.out;
    int tid_ = threadIdx.x; asm volatile("" : "+v"(tid_));
    const int tid = tid_, lane = tid & 63, w = tid >> 6;
    for (int blk = blockIdx.x; blk < T_ / 64; blk += gridDim.x) {
        const int b = (blk * 64) >> 13;
        __syncthreads();
        for (int col = tid; col < 2048; col += 512) {
            float s0 = p.b_ada[col], s1 = 1.0f + p.b_ada[2048 + col];
#pragma unroll
            for (int ks = 0; ks < 8; ++ks) { s0 += MODP[(ks * 2 + b) * 6144 + col]; s1 += MODP[(ks * 2 + b) * 6144 + 2048 + col]; }
            shl[col] = s0; scl[col] = s1;
        }
        __syncthreads();
#pragma unroll 4
        for (int i = 0; i < 8; ++i) {
            const int row = blk * 64 + w * 8 + i;
            const float* xr = p.x + (size_t)row * 2048;
            f32x4 v[8]; float ss = 0.f;
#pragma unroll
            for (int e = 0; e < 8; ++e) { v[e] = *(const f32x4*)(xr + lane * 4 + 256 * e); ss += v[e][0] * v[e][0] + v[e][1] * v[e][1] + v[e][2] * v[e][2] + v[e][3] * v[e][3]; }
            ss = wave_sum(ss);
            const float rstd = rsqrtf(ss * (1.0f / 2048.0f) + EPS);
#pragma unroll
            for (int e = 0; e < 8; ++e) {
                const int col = lane * 4 + 256 * e;
                const f32x4 nw = *(const f32x4*)(p.npre + col), sh = *(const f32x4*)(shl + col), sc = *(const f32x4*)(scl + col);
                float r[4];
#pragma unroll
                for (int k = 0; k < 4; ++k) r[k] = v[e][k] * rstd * nw[k] * sc[k] + sh[k];
                *(u32x2*)(H + (size_t)row * 2048 + col) = pack4(r[0], r[1], r[2], r[3]);
            }
        }
    }
}

__device__ __forceinline__ void conv_item(const bf16_t* P1, const bf16_t* HB, int b, int c, int t, int col, const float* cw  , int cwstride, float (&y)[8]) {
    const size_t row0 = (size_t)b * SEQ_ + (size_t)c * 64;
    u32x4 xv[4];
    const int cp = c > 0 ? c - 1 : 0;
#pragma unroll
    for (int j = 0; j < 4; ++j) {
        const int tt = t - 3 + j;
        const bf16_t* src = (tt >= 0) ? (P1 + (row0 + tt) * LDP + col) : (HB + ((size_t)(b * 128 + cp) * 3 + (tt + 3)) * 10240 + col);
        xv[j] = *(const u32x4*)src;
        if (tt < 0 && c == 0) xv[j] = (u32x4){0u, 0u, 0u, 0u};
    }
#pragma unroll
    for (int e = 0; e < 8; ++e) y[e] = 0.f;
#pragma unroll
    for (int j = 0; j < 4; ++j) {
        float xf[8]; unpack8(xv[j], xf);
        const f32x4 w0 = *(const f32x4*)(cw + j * cwstride), w1 = *(const f32x4*)(cw + j * cwstride + 4);
#pragma unroll
        for (int e = 0; e < 4; ++e) { y[e] += xf[e] * w0[e]; y[4 + e] += xf[4 + e] * w1[e]; }
    }
#pragma unroll
    for (int e = 0; e < 8; ++e) y[e] = siluf_(y[e]);
}

__device__ void prep_gdn(const Params& p, unsigned char* smem, int unit0) {
    bf16_t* P1 = (bf16_t*)(p.ws + OFF_P1); const bf16_t* HB = (const bf16_t*)(p.ws + OFF_HB);
    const float* SM = (const float*)(p.ws + OFF_SM); bf16_t* WB = (bf16_t*)(p.ws + OFF_WB); float* GC = (float*)(p.ws + OFF_GC);
    bf16_t* AT = (bf16_t*)p.out + (size_t)T_ * 2048;
    int tid_ = threadIdx.x; asm volatile("" : "+v"(tid_));
    const int tid = tid_, hb = tid >> 8, ht = tid & 255, lane = tid & 63, wl = (tid >> 6) & 3, l15 = lane & 15, quad = lane >> 4;
    float* cwl = (float*)smem;
    unsigned char* hbase = smem + 4096 + hb * 69120;
    bf16_t* Qn = (bf16_t*)hbase;
    bf16_t* Kn = Qn + 64 * 136;
    float* KKl = (float*)(Kn + 64 * 136);
    float* QKl = KKl + 64 * 64;
    float* gcl = QKl + 64 * 64;
    float* btl = gcl + 128;
    float* btg = btl + 128;
    const int unit = unit0 + hb;
    const int c = unit & 127, qkh = (unit >> 7) & 15, b = unit >> 11;
    const size_t row0 = (size_t)b * SEQ_ + (size_t)c * 64;
    const int hs = ht >> 7, js = ht & 127, hsol = qkh * 2 + hs;
    bf16_t xrw[67];
    float cw0, cw1, cw2, cw3;
    {
        const int col = 4096 + hsol * 128 + js;
#pragma unroll
        for (int tt = 0; tt < 3; ++tt) xrw[tt] = c > 0 ? HB[((size_t)(b * 128 + (c - 1)) * 3 + tt) * 10240 + col] : (bf16_t)0;
#pragma unroll
        for (int tt = 0; tt < 64; ++tt) xrw[3 + tt] = P1[(row0 + tt) * LDP + col];
        cw0 = p.gconv[col]; cw1 = p.gconv[8192 + col]; cw2 = p.gconv[2 * 8192 + col]; cw3 = p.gconv[3 * 8192 + col];
    }
    __syncthreads();
    for (int i = tid; i < 1024; i += 512) { const int j = i >> 8, ch = i & 255; cwl[i] = p.gconv[(size_t)j * 8192 + (ch >> 7) * 2048 + qkh * 128 + (ch & 127)]; }
    __syncthreads();
#pragma unroll
    for (int r = 0; r < 8; ++r) {
        const int item = ht + 256 * r, chg = item & 15, t = (item >> 4) & 63, which = item >> 10;
        float y[8];
        conv_item(P1, HB, b, c, t, which * 2048 + qkh * 128 + chg * 8, cwl + which * 128 + chg * 8, 256, y);
        float ss = 0.f;
#pragma unroll
        for (int e = 0; e < 8; ++e) ss += y[e] * y[e];
        ss += __shfl_xor(ss, 1); ss += __shfl_xor(ss, 2); ss += __shfl_xor(ss, 4); ss += __shfl_xor(ss, 8);
        const float sc = rsqrtf(ss + EPS) * (which == 0 ? 0.08838834764831845f : 1.0f);
#pragma unroll
        for (int e = 0; e < 8; ++e) y[e] *= sc;
        *(u32x4*)((which == 0 ? Qn : Kn) + t * 136 + chg * 8) = pack8(y);
    }
    if (wl < 2) {
        const int h = qkh * 2 + wl;
        const float ap = SM[(size_t)h * T_ + row0 + lane], bp = SM[(size_t)(32 + h) * T_ + row0 + lane];
        const float xx = ap + p.dtb[h];
        const float sp = fmaxf(xx, 0.f) + log1pf(expf(-fabsf(xx)));
        const float g = -expf(p.Alog[h]) * sp;
        const float gcum = wave_scan_add(g, lane);
        const float beta_ = sigmoidf_(bp);
        gcl[wl * 64 + lane] = gcum; btl[wl * 64 + lane] = beta_; btg[wl * 64 + lane] = beta_ * __expf(gcum);
        GC[(size_t)(b * 32 + h) * SEQ_ + c * 64 + lane] = gcum;
    }
    __syncthreads();
#pragma unroll
    for (int i = 0; i < 8; ++i) {
        const int idx = wl * 8 + i, mat = idx >> 4, ti = (idx >> 2) & 3, tj = idx & 3;
        const bf16_t* Am = mat ? Qn : Kn;
        f32x4 a = (f32x4){0.f, 0.f, 0.f, 0.f};
#pragma unroll
        for (int kk = 0; kk < 4; ++kk) {
            const bf16x8 af = *(const bf16x8*)(Am + (16 * ti + l15) * 136 + kk * 32 + quad * 8);
            const bf16x8 bf = *(const bf16x8*)(Kn + (16 * tj + l15) * 136 + kk * 32 + quad * 8);
            a = mfma16(af, bf, a);
        }
        float* dst = mat ? QKl : KKl;
#pragma unroll
        for (int j = 0; j < 4; ++j) dst[(16 * ti + quad * 4 + j) * 64 + 16 * tj + l15] = a[j];
    }
    __syncthreads();
    {
        const int j = ht & 63;
        const float g0j = gcl[j], g1j = gcl[64 + j];
        bf16_t* atp0 = AT + ((size_t)(b * 32 + qkh * 2) * 128 + c) * 4096;
        bf16_t* atp1 = atp0 + (size_t)128 * 4096;
#pragma unroll
        for (int r = 0; r < 16; ++r) {
            const int i = (ht >> 6) + 4 * r;
            const float kk = KKl[i * 64 + j], qk = QKl[i * 64 + j];
            const float d0 = __expf(fminf(gcl[i] - g0j, 0.f)), d1 = __expf(fminf(gcl[64 + i] - g1j, 0.f));
            KKl[i * 64 + j] = (j < i) ? btl[i] * kk * d0 : 0.f;
            QKl[i * 64 + j] = (j < i) ? btl[64 + i] * kk * d1 : 0.f;
            atp0[i * 64 + j] = f2bf((j <= i) ? qk * d0 : 0.f);
            atp1[i * 64 + j] = f2bf((j <= i) ? qk * d1 : 0.f);
        }
    }
    f32x2 sol[64];
    {
        const float* bts = btl + hs * 64; const float* bgs = btg + hs * 64;
#pragma unroll
        for (int t = 0; t < 64; ++t) {
            const float y = cw0 * bf2f(xrw[t]) + cw1 * bf2f(xrw[t + 1]) + cw2 * bf2f(xrw[t + 2]) + cw3 * bf2f(xrw[t + 3]);
            sol[t].x = siluf_(y) * bts[t];
            sol[t].y = bf2f(Kn[t * 136 + js]) * bgs[t];
        }
    }
    __syncthreads();
    {
        const float* Ah = KKl + hs * 4096;
#pragma unroll
        for (int i = 1; i < 64; ++i) {
            f32x4 av[16];
#pragma unroll
            for (int j4 = 0; j4 < (i + 3) / 4; ++j4) av[j4] = *(const f32x4*)(Ah + i * 64 + j4 * 4);
            f32x2 s0 = sol[i], s1 = (f32x2){0.f, 0.f};
#pragma unroll
            for (int j4 = 0; j4 < (i + 3) / 4; ++j4) {
                s0 -= (f32x2){av[j4][0], av[j4][0]} * sol[j4 * 4 + 0]; s1 -= (f32x2){av[j4][1], av[j4][1]} * sol[j4 * 4 + 1];
                s0 -= (f32x2){av[j4][2], av[j4][2]} * sol[j4 * 4 + 2]; s1 -= (f32x2){av[j4][3], av[j4][3]} * sol[j4 * 4 + 3];
            }
            sol[i] = s0 + s1;
        }
        bf16_t* du = P1 + row0 * LDP + 4096 + hsol * 128 + js;
        bf16_t* dw = WB + row0 * 4096 + hsol * 128 + js;
#pragma unroll
        for (int t = 0; t < 64; ++t) { du[(size_t)t * LDP] = f2bf(sol[t].x); dw[(size_t)t * 4096] = f2bf(sol[t].y); if ((t & 7) == 7) asm volatile("" ::: "memory"); }
    }
#pragma unroll
    for (int r = 0; r < 4; ++r) {
        const int pce = ht + 256 * r;
        { const int t = pce >> 4, seg = pce & 15; *(u32x4*)(P1 + (row0 + t) * LDP + qkh * 128 + seg * 8) = *(const u32x4*)(Qn + t * 136 + seg * 8); }
        { const int dk = pce >> 3, t0 = (pce & 7) * 8;
          float f[8];
#pragma unroll
          for (int e = 0; e < 8; ++e) f[e] = bf2f(Kn[(t0 + e) * 136 + dk]);
          *(u32x4*)(P1 + (row0 + (pce >> 4)) * LDP + 2048 + qkh * 128 + (pce & 15) * 8) = pack8(f); }
    }
}

__device__ void prep_mlstm(const Params& p, unsigned char* smem, int unit0) {
    bf16_t* P1 = (bf16_t*)(p.ws + OFF_P1); const bf16_t* HB = (const bf16_t*)(p.ws + OFF_HB); const float* SM = (const float*)(p.ws + OFF_SM);
    bf16_t* KT = (bf16_t*)(p.ws + OFF_WT1);
    f32x4* MS = (f32x4*)(p.ws + OFF_WT1 + 33554432);
    int tid_ = threadIdx.x; asm volatile("" : "+v"(tid_));
    const int tid = tid_, hb = tid >> 8, ht = tid & 255, lane = tid & 63, wl = (tid >> 6) & 3;
    float* cwl = (float*)smem;
    bf16_t* Kn = (bf16_t*)(smem + 4096 + hb * 17408);
    const int unit = unit0 + hb;
    const int c = unit & 127, hd = (unit >> 7) & 7, b = unit >> 10;
    const size_t row0 = (size_t)b * SEQ_ + (size_t)c * 64;
    __syncthreads();
    for (int i = tid; i < 1024; i += 512) { const int j = i >> 8, ch = i & 255; cwl[i] = p.mconv[(size_t)j * 2048 + (ch >> 7) * 1024 + hd * 128 + (ch & 127)]; }
    __syncthreads();
    u32x4 res[8];
#pragma unroll
    for (int r = 0; r < 8; ++r) {
        const int item = ht + 256 * r, chg = item & 15, t = (item >> 4) & 63, which = item >> 10;
        float y[8];
        conv_item(P1, HB, b, c, t, 8192 + which * 1024 + hd * 128 + chg * 8, cwl + which * 128 + chg * 8, 256, y);
        if (which == 0) {
#pragma unroll
            for (int e = 0; e < 8; ++e) y[e] *= 0.08838834764831845f;
        }
        res[r] = pack8(y);
        if (which == 1) *(u32x4*)(Kn + t * 136 + chg * 8) = res[r];
    }
    if (wl == 0) {
        const float ip = SM[(size_t)(64 + hd) * T_ + row0 + lane] + p.mbi[hd], fp = SM[(size_t)(72 + hd) * T_ + row0 + lane] + p.mbf[hd];
        const float lf = fminf(fp, 0.f) - log1pf(expf(-fabsf(fp)));
        const float bc = wave_scan_add(lf, lane);
        const float av = ip - bc;
        const float cm = wave_scan_max(av, lane);
        MS[(size_t)(b * 8 + hd) * SEQ_ + c * 64 + lane] = (f32x4){bc, av, cm, 0.f};
    }
    __syncthreads();
#pragma unroll
    for (int r = 0; r < 8; ++r) {
        const int item = ht + 256 * r, chg = item & 15, t = (item >> 4) & 63, which = item >> 10;
        *(u32x4*)(P1 + (row0 + t) * LDP + 8192 + which * 1024 + hd * 128 + chg * 8) = res[r];
    }
#pragma unroll
    for (int r = 0; r < 4; ++r) {
        const int pce = ht + 256 * r, dk = pce >> 3, t0 = (pce & 7) * 8;
        float f[8];
#pragma unroll
        for (int e = 0; e < 8; ++e) f[e] = bf2f(Kn[(t0 + e) * 136 + dk]);
        *(u32x4*)(KT + ((size_t)((b * 8 + hd) * 128 + c)) * 8192 + pce * 8) = pack8(f);
    }
}

__device__ void gdn_scan(const Params& p, unsigned char* smem, int unit) {
    bf16_t* P1 = (bf16_t*)(p.ws + OFF_P1); const bf16_t* WB = (const bf16_t*)(p.ws + OFF_WB); const float* GC = (const float*)(p.ws + OFF_GC);
    float* RSA = (float*)(p.ws + OFF_RSA);
    const bf16_t* AT = (const bf16_t*)p.out + (size_t)T_ * 2048;
    bf16_t* Wl = (bf16_t*)smem;
    bf16_t* Ql = Wl + 64 * 136;
    bf16_t* St = Ql + 64 * 136;
    bf16_t* Kt = St + 64 * 136;
    bf16_t* At = Kt + 128 * 72;
    bf16_t* Vt = At + 64 * 72;
    bf16_t* V2 = Vt + 64 * 72;
    bf16_t* Ul = V2 + 64 * 72;
    bf16_t* Ol = Ul + 64 * 72;
    float* gcl = (float*)(Ol + 64 * 72);
    int tid_ = threadIdx.x; asm volatile("" : "+v"(tid_));
    const int tid = tid_, lane = tid & 63, w = tid >> 6, l15 = lane & 15, quad = lane >> 4;
    const int bh = unit >> 1, b = bh >> 5, h = bh & 31, qkh = h >> 1, sl = unit & 1, dv0 = sl * 64;
    const size_t rowb = (size_t)b * SEQ_;
    u32x4 rw[2][2], rq[2][2], rk[2][2], ra[2], ru[2]; float rg[2];
#define GDN_ISSUE(S, cc) do { const size_t r0_ = rowb + (size_t)(cc) * 64; \
        _Pragma("unroll") for (int i_ = 0; i_ < 2; ++i_) { const int p_ = tid + 512 * i_, t_ = p_ >> 4, s_ = p_ & 15; \
            rw[S][i_] = *(const u32x4*)(WB + (r0_ + t_) * 4096 + h * 128 + s_ * 8); \
            rq[S][i_] = *(const u32x4*)(P1 + (r0_ + t_) * LDP + qkh * 128 + s_ * 8); \
            rk[S][i_] = *(const u32x4*)(P1 + (r0_ + t_) * LDP + 2048 + qkh * 128 + s_ * 8); } \
        ra[S] = *(const u32x4*)(AT + ((size_t)(b * 32 + h) * 128 + (cc)) * 4096 + tid * 8); \
        ru[S] = *(const u32x4*)(P1 + (r0_ + (tid >> 3)) * LDP + 4096 + h * 128 + dv0 + (tid & 7) * 8); \
        if (w == 0) rg[S] = GC[(size_t)(b * 32 + h) * SEQ_ + (cc) * 64 + lane]; } while (0)
#define GDN_STAGE1(S) do { \
        _Pragma("unroll") for (int i_ = 0; i_ < 2; ++i_) { const int p_ = tid + 512 * i_, t_ = p_ >> 4, s_ = p_ & 15; \
            *(u32x4*)(Wl + t_ * 136 + s_ * 8) = rw[S][i_]; *(u32x4*)(Ql + t_ * 136 + s_ * 8) = rq[S][i_]; } \
        *(u32x4*)(Ul + (tid >> 3) * 72 + (tid & 7) * 8) = ru[S]; \
        if (w == 0) gcl[lane] = rg[S]; } while (0)
#define GDN_STAGE2(S) do { \
        _Pragma("unroll") for (int i_ = 0; i_ < 2; ++i_) { const int p_ = tid + 512 * i_; \
            *(u32x4*)(Kt + (p_ >> 3) * 72 + (p_ & 7) * 8) = rk[S][i_]; } \
        *(u32x4*)(At + (tid >> 3) * 72 + (tid & 7) * 8) = ra[S]; } while (0)
    f32x4 Sacc[4];
#pragma unroll
    for (int n = 0; n < 4; ++n) Sacc[n] = (f32x4){0.f, 0.f, 0.f, 0.f};
    __syncthreads();
    for (int i = tid; i < 64 * 136 / 8; i += 512) *(u32x4*)(St + i * 8) = (u32x4){0u, 0u, 0u, 0u};
    GDN_ISSUE(0, 0); GDN_STAGE1(0); GDN_STAGE2(0);
    GDN_ISSUE(0, 1); GDN_ISSUE(1, 2);
    __syncthreads();
    const int tt = w >> 1, nb = (w & 1) * 2;
    for (int c2 = 0; c2 < 128; c2 += 2) {
#pragma unroll
      for (int par = 0; par < 2; ++par) {
        const int c = c2 + par;
        f32x4 ws[2], qs[2];
#pragma unroll
        for (int n = 0; n < 2; ++n) { ws[n] = (f32x4){0.f, 0.f, 0.f, 0.f}; qs[n] = (f32x4){0.f, 0.f, 0.f, 0.f}; }
        {
            bf16x8 aw[4], aq[4], bs[2][4];
#pragma unroll
            for (int kk = 0; kk < 4; ++kk) {
                aw[kk] = *(const bf16x8*)(Wl + (16 * tt + l15) * 136 + kk * 32 + quad * 8);
                bs[0][kk] = *(const bf16x8*)(St + (16 * nb + l15) * 136 + kk * 32 + quad * 8);
                bs[1][kk] = *(const bf16x8*)(St + (16 * (nb + 1) + l15) * 136 + kk * 32 + quad * 8);
                aq[kk] = *(const bf16x8*)(Ql + (16 * tt + l15) * 136 + kk * 32 + quad * 8);
            }
#pragma unroll
            for (int kk = 0; kk < 4; ++kk)
#pragma unroll
                for (int n = 0; n < 2; ++n) ws[n] = mfma16(aw[kk], bs[n][kk], ws[n]);
#pragma unroll
            for (int kk = 0; kk < 4; ++kk)
#pragma unroll
                for (int n = 0; n < 2; ++n) qs[n] = mfma16(aq[kk], bs[n][kk], qs[n]);
        }
        const float gl = gcl[63];
        float gr[4];
#pragma unroll
        for (int j = 0; j < 4; ++j) gr[j] = gcl[16 * tt + quad * 4 + j];
#pragma unroll
        for (int n = 0; n < 2; ++n) {
            const int dvc = 16 * (nb + n) + l15;
            float vn[4], v2[4];
#pragma unroll
            for (int j = 0; j < 4; ++j) {
                vn[j] = bf2f(Ul[(16 * tt + quad * 4 + j) * 72 + dvc]) - ws[n][j];
                v2[j] = vn[j] * __expf(gl - gr[j]);
                qs[n][j] *= __expf(gr[j]);
            }
            *(u32x2*)(Vt + dvc * 72 + 16 * tt + quad * 4) = pack4(vn[0], vn[1], vn[2], vn[3]);
            *(u32x2*)(V2 + dvc * 72 + 16 * tt + quad * 4) = pack4(v2[0], v2[1], v2[2], v2[3]);
        }
        __syncthreads();
        bf16x8 ak2[2], bv2[4][2];
        {
            bf16x8 aa[2], bv[2][2];
#pragma unroll
            for (int kk = 0; kk < 2; ++kk) {
                aa[kk] = *(const bf16x8*)(At + (16 * tt + l15) * 72 + kk * 32 + quad * 8);
                bv[0][kk] = *(const bf16x8*)(Vt + (16 * nb + l15) * 72 + kk * 32 + quad * 8);
                bv[1][kk] = *(const bf16x8*)(Vt + (16 * (nb + 1) + l15) * 72 + kk * 32 + quad * 8);
            }
#pragma unroll
            for (int kk = 0; kk < 2; ++kk) {
                ak2[kk] = *(const bf16x8*)(Kt + (16 * w + l15) * 72 + kk * 32 + quad * 8);
#pragma unroll
                for (int n = 0; n < 4; ++n) bv2[n][kk] = *(const bf16x8*)(V2 + (16 * n + l15) * 72 + kk * 32 + quad * 8);
            }
#pragma unroll
            for (int kk = 0; kk < 2; ++kk)
#pragma unroll
                for (int n = 0; n < 2; ++n) qs[n] = mfma16(aa[kk], bv[n][kk], qs[n]);
        }
#pragma unroll
        for (int n = 0; n < 2; ++n)
#pragma unroll
            for (int j = 0; j < 4; ++j) Ol[(16 * tt + quad * 4 + j) * 72 + 16 * (nb + n) + l15] = f2bf(qs[n][j]);
        const float gt = __expf(gl);
#pragma unroll
        for (int n = 0; n < 4; ++n) Sacc[n] *= gt;
#pragma unroll
        for (int kk = 0; kk < 2; ++kk)
#pragma unroll
            for (int n = 0; n < 4; ++n) Sacc[n] = mfma16(ak2[kk], bv2[n][kk], Sacc[n]);
#pragma unroll
        for (int n = 0; n < 4; ++n) *(u32x2*)(St + (16 * n + l15) * 136 + 16 * w + quad * 4) = pack4(Sacc[n][0], Sacc[n][1], Sacc[n][2], Sacc[n][3]);
        if (c + 1 < 128) { if (par == 0) GDN_STAGE1(0); else GDN_STAGE1(1); }
        __syncthreads();
        {
            const int t = tid >> 3, seg = tid & 7;
            const u32x4 o = *(const u32x4*)(Ol + t * 72 + seg * 8);
            const size_t row = rowb + (size_t)c * 64 + t;
            *(u32x4*)(P1 + row * LDP + 4096 + h * 128 + dv0 + seg * 8) = o;
            float f[8]; unpack8(o, f);
            float ss = 0.f;
#pragma unroll
            for (int e = 0; e < 8; ++e) ss += f[e] * f[e];
            ss += __shfl_xor(ss, 1); ss += __shfl_xor(ss, 2); ss += __shfl_xor(ss, 4);
            if (seg == 0) RSA[(size_t)((b * 32 + h) * 2 + sl) * SEQ_ + c * 64 + t] = ss;
        }
        if (par == 0) { if (c + 1 < 128) GDN_STAGE2(0); if (c + 3 < 128) GDN_ISSUE(0, c + 3); }
        else          { if (c + 1 < 128) GDN_STAGE2(1); if (c + 3 < 128) GDN_ISSUE(1, c + 3); }
      }
    }
#undef GDN_ISSUE
#undef GDN_STAGE1
#undef GDN_STAGE2
}

__device__ void mlstm_scan(const Params& p, unsigned char* smem, int unit) {
    bf16_t* P1 = (bf16_t*)(p.ws + OFF_P1); float* RSB = (float*)(p.ws + OFF_RSB);
    const bf16_t* KT = (const bf16_t*)(p.ws + OFF_WT1); const f32x4* MS = (const f32x4*)(p.ws + OFF_WT1 + 33554432);
    bf16_t* Qc = (bf16_t*)smem;
    bf16_t* Kc = Qc + 64 * 136;
    bf16_t* Ct = Kc + 64 * 136;
    bf16_t* Kt = Ct + 48 * 136;
    bf16_t* Sl = Kt + 128 * 72;
    bf16_t* Vx = Sl + 64 * 72;
    bf16_t* V2 = Vx + 48 * 72;
    bf16_t* Ol = V2 + 48 * 72;
    float* aL = (float*)(Ol + 64 * 40);
    float* ML = aL + 64; float* wiL = ML + 64; float* enL = wiL + 64;
    int tid_ = threadIdx.x; asm volatile("" : "+v"(tid_));
    const int tid = tid_, lane = tid & 63, w = tid >> 6, l15 = lane & 15, quad = lane >> 4;
    const int bh = unit >> 3, b = bh >> 3, hd = bh & 7, sl = unit & 7, dv0 = sl * 32;
    const size_t rowb = (size_t)b * SEQ_;
    u32x4 rq[2][2], rk[2][2], rkt[2][2], rv[2]; f32x4 rms[2];
    float m_state = 0.f, cd = 1.f;
#define ML_ISSUE(S, cc) do { const size_t r0_ = rowb + (size_t)(cc) * 64; \
        _Pragma("unroll") for (int i_ = 0; i_ < 2; ++i_) { const int p_ = tid + 512 * i_, t_ = p_ >> 4, s_ = p_ & 15; \
            rq[S][i_] = *(const u32x4*)(P1 + (r0_ + t_) * LDP + 8192 + hd * 128 + s_ * 8); \
            rk[S][i_] = *(const u32x4*)(P1 + (r0_ + t_) * LDP + 9216 + hd * 128 + s_ * 8); \
            rkt[S][i_] = *(const u32x4*)(KT + ((size_t)((b * 8 + hd) * 128 + (cc))) * 8192 + p_ * 8); } \
        if (tid < 256) rv[S] = *(const u32x4*)(P1 + (r0_ + (tid >> 2)) * LDP + 10240 + hd * 256 + dv0 + (tid & 3) * 8); \
        rms[S] = MS[(size_t)(b * 8 + hd) * SEQ_ + (cc) * 64 + lane]; } while (0)
    float wk_s = 0.f, wi_s = 0.f, en_s = 0.f;
#define ML_STAGE1(S) do { \
        const float bc_ = rms[S].x, a_ = rms[S].y, cm_ = rms[S].z; \
        const float M_ = fmaxf(m_state, cm_); \
        const float M63_ = __shfl(M_, 63), bl_ = __shfl(bc_, 63); \
        wk_s = __expf(a_ - M63_); wi_s = __expf(m_state - M_); en_s = __expf(-(bc_ + M_)); \
        if (w == 0) { aL[lane] = a_; ML[lane] = M_; } \
        cd = __expf(m_state - M63_); m_state = bl_ + M63_; \
        _Pragma("unroll") for (int i_ = 0; i_ < 2; ++i_) { const int p_ = tid + 512 * i_, t_ = p_ >> 4, s_ = p_ & 15; \
            *(u32x4*)(Qc + t_ * 136 + s_ * 8) = rq[S][i_]; *(u32x4*)(Kc + t_ * 136 + s_ * 8) = rk[S][i_]; } } while (0)
#define ML_STAGE2(S) do { \
        if (w == 0) { wiL[lane] = wi_s; enL[lane] = en_s; } \
        _Pragma("unroll") for (int i_ = 0; i_ < 2; ++i_) { const int p_ = tid + 512 * i_; \
            *(u32x4*)(Kt + (p_ >> 3) * 72 + (p_ & 7) * 8) = rkt[S][i_]; } \
        if (tid < 256) { const int t_ = tid >> 2, d0_ = (tid & 3) * 8; const float wkt_ = __shfl(wk_s, t_); \
            _Pragma("unroll") for (int e_ = 0; e_ < 8; ++e_) { const int ee_ = (e_ + 2 * (tid & 3)) & 7; \
                const unsigned w01_ = (ee_ & 2) ? rv[S].y : rv[S].x, w23_ = (ee_ & 2) ? rv[S].w : rv[S].z, ws_ = (ee_ & 4) ? w23_ : w01_; \
                const unsigned hv_ = (ee_ & 1) ? (ws_ >> 16) : (ws_ & 0xffffu); \
                Vx[(d0_ + ee_) * 72 + t_] = (bf16_t)hv_; V2[(d0_ + ee_) * 72 + t_] = f2bf(__uint_as_float(hv_ << 16) * wkt_); } } \
        if (w == 4) { Vx[32 * 72 + lane] = (bf16_t)0x3f80u; V2[32 * 72 + lane] = f2bf(wk_s); } } while (0)
    f32x4 Cacc[3];
#pragma unroll
    for (int n = 0; n < 3; ++n) Cacc[n] = (f32x4){0.f, 0.f, 0.f, 0.f};
    __syncthreads();
    for (int i = tid; i < 48 * 136 / 8; i += 512) *(u32x4*)(Ct + i * 8) = (u32x4){0u, 0u, 0u, 0u};
    for (int i = tid; i < 2 * 48 * 72 / 8; i += 512) *(u32x4*)(Vx + i * 8) = (u32x4){0u, 0u, 0u, 0u};
    __syncthreads();
    ML_ISSUE(0, 0); ML_STAGE1(0); ML_STAGE2(0);
    ML_ISSUE(0, 1); ML_ISSUE(1, 2);
    __syncthreads();
    const int tt = w >> 1, half = w & 1;
    for (int c2 = 0; c2 < 128; c2 += 2) {
#pragma unroll
      for (int par = 0; par < 2; ++par) {
        const int c = c2 + par;
        const float cd_cur = cd;
#pragma unroll
        for (int e = 0; e < 2; ++e) {
            const int idx = 2 * w + e, tj = idx >> 2, ti = idx & 3;
            f32x4 a = (f32x4){0.f, 0.f, 0.f, 0.f};
            if (tj <= ti) {
                bf16x8 ak[4], bq[4];
#pragma unroll
                for (int kk = 0; kk < 4; ++kk) {
                    ak[kk] = *(const bf16x8*)(Kc + (16 * tj + l15) * 136 + kk * 32 + quad * 8);
                    bq[kk] = *(const bf16x8*)(Qc + (16 * ti + l15) * 136 + kk * 32 + quad * 8);
                }
#pragma unroll
                for (int kk = 0; kk < 4; ++kk) a = mfma16(ak[kk], bq[kk], a);
            }
            const int ig = 16 * ti + l15;
            const float Mi = ML[ig];
            float sv[4];
#pragma unroll
            for (int j = 0; j < 4; ++j) { const int jg = 16 * tj + quad * 4 + j; sv[j] = (jg <= ig) ? a[j] * __expf(fminf(aL[jg] - Mi, 0.f)) : 0.f; }
            *(u32x2*)(Sl + ig * 72 + 16 * tj + quad * 4) = pack4(sv[0], sv[1], sv[2], sv[3]);
        }
        f32x4 qc[2];
        qc[0] = (f32x4){0.f, 0.f, 0.f, 0.f}; qc[1] = (f32x4){0.f, 0.f, 0.f, 0.f};
        {
            bf16x8 aq[4], b0[4], b1[4];
#pragma unroll
            for (int kk = 0; kk < 4; ++kk) {
                aq[kk] = *(const bf16x8*)(Qc + (16 * tt + l15) * 136 + kk * 32 + quad * 8);
                b0[kk] = *(const bf16x8*)(Ct + (16 * half + l15) * 136 + kk * 32 + quad * 8);
                b1[kk] = *(const bf16x8*)(Ct + (32 + l15) * 136 + kk * 32 + quad * 8);
            }
#pragma unroll
            for (int kk = 0; kk < 4; ++kk) { qc[0] = mfma16(aq[kk], b0[kk], qc[0]); qc[1] = mfma16(aq[kk], b1[kk], qc[1]); }
        }
        __syncthreads();
        bf16x8 ak3[2], bv3[3][2];
        {
            float wi[4], en[4];
#pragma unroll
            for (int j = 0; j < 4; ++j) { wi[j] = wiL[16 * tt + quad * 4 + j]; en[j] = enL[16 * tt + quad * 4 + j]; qc[0][j] *= wi[j]; qc[1][j] *= wi[j]; }
            {
                bf16x8 as[2], b0[2], b1[2];
#pragma unroll
                for (int kk = 0; kk < 2; ++kk) {
                    as[kk] = *(const bf16x8*)(Sl + (16 * tt + l15) * 72 + kk * 32 + quad * 8);
                    b0[kk] = *(const bf16x8*)(Vx + (16 * half + l15) * 72 + kk * 32 + quad * 8);
                    b1[kk] = *(const bf16x8*)(Vx + (32 + l15) * 72 + kk * 32 + quad * 8);
                }
#pragma unroll
                for (int kk = 0; kk < 2; ++kk) {
                    ak3[kk] = *(const bf16x8*)(Kt + (16 * w + l15) * 72 + kk * 32 + quad * 8);
#pragma unroll
                    for (int n = 0; n < 3; ++n) bv3[n][kk] = *(const bf16x8*)(V2 + (16 * n + l15) * 72 + kk * 32 + quad * 8);
                }
#pragma unroll
                for (int kk = 0; kk < 2; ++kk) { qc[0] = mfma16(as[kk], b0[kk], qc[0]); qc[1] = mfma16(as[kk], b1[kk], qc[1]); }
            }
#pragma unroll
            for (int j = 0; j < 4; ++j) {
                const float den = __shfl(qc[1][j], quad * 16);
                const float hv = qc[0][j] * __builtin_amdgcn_rcpf(fmaxf(fabsf(den), en[j]));
                Ol[(16 * tt + quad * 4 + j) * 40 + 16 * half + l15] = f2bf(hv);
            }
        }
#pragma unroll
        for (int n = 0; n < 3; ++n) Cacc[n] *= cd_cur;
#pragma unroll
        for (int kk = 0; kk < 2; ++kk)
#pragma unroll
            for (int n = 0; n < 3; ++n) Cacc[n] = mfma16(ak3[kk], bv3[n][kk], Cacc[n]);
#pragma unroll
        for (int n = 0; n < 3; ++n) *(u32x2*)(Ct + (16 * n + l15) * 136 + 16 * w + quad * 4) = pack4(Cacc[n][0], Cacc[n][1], Cacc[n][2], Cacc[n][3]);
        if (c + 1 < 128) { if (par == 0) ML_STAGE1(0); else ML_STAGE1(1); }
        __syncthreads();
        if (tid < 256) {
            const int t = tid >> 2, seg = tid & 3;
            const u32x4 o = *(const u32x4*)(Ol + t * 40 + seg * 8);
            const size_t row = rowb + (size_t)c * 64 + t;
            *(u32x4*)(P1 + row * LDP + 10240 + hd * 256 + dv0 + seg * 8) = o;
            float f[8]; unpack8(o, f);
            float ss = 0.f;
#pragma unroll
            for (int e = 0; e < 8; ++e) ss += f[e] * f[e];
            ss += __shfl_xor(ss, 1); ss += __shfl_xor(ss, 2);
            if (seg == 0) RSB[(size_t)((b * 8 + hd) * 8 + sl) * SEQ_ + c * 64 + t] = ss;
        }
        if (par == 0) { if (c + 1 < 128) ML_STAGE2(0); if (c + 3 < 128) ML_ISSUE(0, c + 3); }
        else          { if (c + 1 < 128) ML_STAGE2(1); if (c + 3 < 128) ML_ISSUE(1, c + 3); }
      }
    }
#undef ML_ISSUE
#undef ML_STAGE1
#undef ML_STAGE2
}

__device__ void phase_final(const Params& p, unsigned char* smem) {
    float* gl = (float*)smem;
    const float* MODP = (const float*)(p.ws + OFF_MODP);
    const float* OUTF = (const float*)(p.ws + OFF_WB); const float* SSQ = (const float*)(p.ws + OFF_SSQ);
    int tid_ = threadIdx.x; asm volatile("" : "+v"(tid_));
    const int tid = tid_, lane = tid & 63, w = tid >> 6;
    for (int blk = blockIdx.x; blk < T_ / 64; blk += gridDim.x) {
        const int b = (blk * 64) >> 13;
        __syncthreads();
        for (int col = tid; col < 2048; col += 512) {
            float s0 = p.b_ada[4096 + col];
#pragma unroll
            for (int ks = 0; ks < 8; ++ks) s0 += MODP[(ks * 2 + b) * 6144 + 4096 + col];
            gl[col] = s0;
        }
        __syncthreads();
#pragma unroll 4
        for (int i = 0; i < 8; ++i) {
            const int row = blk * 64 + w * 8 + i;
            float ss = (lane < 32) ? SSQ[(size_t)row * 32 + lane] : 0.f;
            ss = wave_sum(ss);
            const float rstd = rsqrtf(ss * (1.0f / 2048.0f) + EPS);
#pragma unroll
            for (int e = 0; e < 8; ++e) {
                const int col = lane * 4 + 256 * e;
                const f32x4 xv = *(const f32x4*)(p.x + (size_t)row * 2048 + col);
                const u32x2 ow = *(const u32x2*)((const bf16_t*)OUTF + (size_t)row * 2048 + col);
                const f32x4 ov = (f32x4){bflo(ow.x), bfhi(ow.x), bflo(ow.y), bfhi(ow.y)};
                const f32x4 nw = *(const f32x4*)(p.npost + col), gv = *(const f32x4*)(gl + col);
                f32x4 r;
#pragma unroll
                for (int k = 0; k < 4; ++k) r[k] = xv[k] + gv[k] * (ov[k] * rstd * nw[k]);
                *(f32x4*)(p.out + (size_t)row * 2048 + col) = r;
            }
        }
    }
}


#define XB_TMO      128
#define XB_XCNT(j)  (256  + 64 * (j))
#define XB_XSUB(j)  (1280 + 64 * (j))
#define XB_XGEN(j)  (2304 + 64 * (j))
#define XB_TOP      3328
#define XB_TOPGEN   3392
#define XCD_BAR_WORDS 3456
#define XB_SPIN_CAP (1u << 21)
__device__ __forceinline__ unsigned xb_ld(unsigned* p)              { return __hip_atomic_load(p, __ATOMIC_RELAXED, __HIP_MEMORY_SCOPE_AGENT); }
__device__ __forceinline__ unsigned xb_add(unsigned* p, unsigned v) { return __hip_atomic_fetch_add(p, v, __ATOMIC_RELAXED, __HIP_MEMORY_SCOPE_AGENT); }
__device__ __forceinline__ unsigned xb_xcc_id() { return (unsigned)__builtin_amdgcn_s_getreg((3 << 11) | 20) & 0xFu; }
#define XB_SPIN(cond, bar) do { unsigned _sp = 0; while (cond) { __builtin_amdgcn_s_sleep(1); \
    if ((++_sp & 255u) == 0u) { if (xb_ld(&(bar)[XB_TMO])) break; if (_sp > XB_SPIN_CAP) { atomicAdd(&(bar)[XB_TMO], 1u); break; } } } } while (0)
__device__ __forceinline__ void xcd_barrier_complete(unsigned* bar, unsigned x, unsigned& nloc, unsigned& nx) {
    const unsigned G = gridDim.x * gridDim.y * gridDim.z;
    unsigned sum, cnt, mine, sp = 0u;
    for (;;) {
        sum = 0u; cnt = 0u; mine = 0u;
#pragma unroll
        for (unsigned j = 0; j < 16; ++j) { const unsigned c = xb_ld(&bar[XB_XCNT(j)]); sum += c; cnt += (c > 0u) ? 1u : 0u; mine = (j == x) ? c : mine; }
        if (sum == G) break;
        __builtin_amdgcn_s_sleep(1);
        if ((++sp & 255u) == 0u) { if (xb_ld(&bar[XB_TMO])) break; if (sp > XB_SPIN_CAP) { atomicAdd(&bar[XB_TMO], 1u); break; } }
    }
    nloc = mine > 0u ? mine : 1u; nx = cnt > 0u ? cnt : 1u;
}
__device__ __forceinline__ void xcd_barrier(unsigned* bar, volatile LAS unsigned* st) {
    asm volatile("s_waitcnt vmcnt(0)" ::: "memory");
    __syncthreads();
    if (threadIdx.x == 0) {
        const unsigned x = xb_xcc_id();
        __builtin_amdgcn_s_waitcnt(0);
        unsigned nloc = st[0], nx = st[1];
        if (nloc == 0u) { xcd_barrier_complete(bar, x, nloc, nx); st[0] = nloc; st[1] = nx; }
        const unsigned old = xb_add(&bar[XB_XSUB(x)], 1u);
        const unsigned gen = old / nloc;
        if (old + 1u == (gen + 1u) * nloc) {
            __builtin_amdgcn_fence(__ATOMIC_RELEASE, "agent");
            asm volatile("s_waitcnt vmcnt(0)" ::: "memory");
            const unsigned og = xb_add(&bar[XB_TOP], 1u);
            const unsigned tg = og / nx;
            if (og + 1u == (tg + 1u) * nx) xb_add(&bar[XB_TOPGEN], 1u);
            else XB_SPIN(xb_ld(&bar[XB_TOPGEN]) == tg, bar);
            __builtin_amdgcn_fence(__ATOMIC_ACQUIRE, "agent");
            xb_add(&bar[XB_XGEN(x)], 1u);
            asm volatile("s_waitcnt vmcnt(0)" ::: "memory");
        } else {
            XB_SPIN(xb_ld(&bar[XB_XGEN(x)]) == gen, bar);
            __builtin_amdgcn_fence(__ATOMIC_ACQUIRE, "agent");
            asm volatile("s_waitcnt vmcnt(0)" ::: "memory");
        }
    }
    __syncthreads();
}

template <int PH>
__global__ void __launch_bounds__(512) mk_kernel(Params p) {
    extern __shared__ __attribute__((aligned(16))) unsigned char smem[];
    LAS unsigned char* lds = (LAS unsigned char*)smem;
    pg8::StaticOrder so;
    unsigned* bar = (unsigned*)(p.ws + OFF_BAR);
    volatile LAS unsigned* st = (volatile LAS unsigned*)(lds + LDS_MAIN);
    if (PH < 0) {
        if (threadIdx.x == 0) { st[0] = 0u; st[1] = 0u; }
        if (blockIdx.x == 0) { for (int i = threadIdx.x; i < XCD_BAR_WORDS; i += 512) __hip_atomic_store(&bar[i], 0u, __ATOMIC_RELAXED, __HIP_MEMORY_SCOPE_AGENT); }
        __syncthreads();
    }
#define SYNC() do { if (PH < 0) xcd_barrier((unsigned*)(p.ws + OFF_BAR), (volatile LAS unsigned*)(lds + LDS_MAIN)); } while (0)
    if (PH < 0 || PH == 0) phase0(p, smem);
    if (PH < 0) cg::this_grid().sync();
    if (PH < 0) { if (threadIdx.x == 0) (void)xb_add(&bar[XB_XCNT(xb_xcc_id())], 1u); }
    if (PH < 0 || PH == 1) phase1(p, smem);
    SYNC();
    if (PH < 0 || PH == 2) {
        pg8::Gemm g{(const bf16_t*)p.out, (const bf16_t*)(p.ws + OFF_WT1), 2048, T_, N1, 2048};
        so.init(T_, N1, gridDim.x, blockIdx.x);
        Epi1 e{(bf16_t*)(p.ws + OFF_P1), (bf16_t*)(p.ws + OFF_HB), (float*)(p.ws + OFF_SM)};
        pg8::gemm_phase(lds, g, so, e);
        { const int nfull = (T_ / 256) * (N1 / 256) - 12 * (int)gridDim.x;
          const int first = (nfull > 0 && nfull < (int)gridDim.x) ? nfull : 0;
          if ((int)blockIdx.x >= first) late_transposes(p, smem, (int)blockIdx.x - first, (int)gridDim.x - first); }
    }
    SYNC();
    if (PH < 0 || PH == 3) {
        for (int u = blockIdx.x * 2; u < 4096; u += gridDim.x * 2) prep_gdn(p, smem, u);
        for (int u = blockIdx.x * 2; u < 2048; u += gridDim.x * 2) prep_mlstm(p, smem, u);
    }
    SYNC();
    if (PH < 0 || PH == 4) {
        for (int u = blockIdx.x; u < 256; u += gridDim.x) {
            if (u < 128) { const int xcd = u & 7, kk = u >> 3, qg = xcd * 4 + (kk >> 2), wi = kk & 3;
                           const int bh = (qg >> 4) * 32 + (qg & 15) * 2 + (wi >> 1);
                           gdn_scan(p, smem, (bh << 1) | (wi & 1)); }
            else         { const int m = u - 128, xcd = m & 7, kk = m >> 3, stream = xcd * 2 + (kk >> 3);
                           mlstm_scan(p, smem, (stream << 3) | (kk & 7)); }
        }
    }
    SYNC();
    if (PH < 0 || PH == 5) {
        pg8::Gemm g{(const bf16_t*)p.out, (const bf16_t*)(p.ws + OFF_WT2), 2048, T_, N2, 2048};
        so.init(T_, N2, gridDim.x, blockIdx.x);
        Epi2 e{(bf16_t*)(p.ws + OFF_P1), (const float*)(p.ws + OFF_RSA), (const float*)(p.ws + OFF_RSB), p.gnw, p.mnw};
        pg8::gemm_phase(lds, g, so, e);
    }
    SYNC();
    if (PH < 0 || PH == 6) {
        so.init(T_, 2048, gridDim.x, blockIdx.x);
        { pg8::Gemm g{(const bf16_t*)(p.ws + OFF_P1) + 4096, (const bf16_t*)(p.ws + OFF_WTA), LDP, T_, 2048, 4096};
          EpiA e{(const bf16_t*)(p.ws + OFF_P1), p.out};
          pg8::gemm_phase(lds, g, so, e); }
        { pg8::Gemm g{(const bf16_t*)(p.ws + OFF_P1) + 10240, (const bf16_t*)(p.ws + OFF_WTB), LDP, T_, 2048, 2048};
          EpiB e{(bf16_t*)(p.ws + OFF_P1), p.out};
          pg8::gemm_phase(lds, g, so, e); }
    }
    SYNC();
    if (PH < 0 || PH == 7) {
        so.init(T_, 2048, gridDim.x, blockIdx.x);
        pg8::Gemm g{(const bf16_t*)(p.ws + OFF_P1) + 8192, (const bf16_t*)(p.ws + OFF_WTO), LDP, T_, 2048, 2048};
        EpiO e{(float*)(p.ws + OFF_WB), (float*)(p.ws + OFF_SSQ)};
        pg8::gemm_phase(lds, g, so, e);
    }
    SYNC();
    if (PH < 0 || PH == 8) phase_final(p, smem);
#undef SYNC
}

#ifndef MK_MULTI
#define MK_MULTI 0
#endif

template <int PH> static void launch_one(const Params& p, hipStream_t stream) {
    hipFuncSetAttribute((const void*)mk_kernel<PH>, hipFuncAttributeMaxDynamicSharedMemorySize, LDS_BYTES);
    hipLaunchKernelGGL(mk_kernel<PH>, dim3(256), dim3(512), LDS_BYTES, stream, p);
}

extern "C" void kernel_launch(void* const* d_in, const int* in_sizes, int n_in, void* d_out, int out_size, void* d_ws, size_t ws_size, hipStream_t stream) {
    Params p{};
    p.x = (const float*)d_in[0]; p.c = (const float*)d_in[1]; p.w_ada = (const float*)d_in[2]; p.b_ada = (const float*)d_in[3];
    p.npre = (const float*)d_in[4]; p.w_in = (const float*)d_in[5]; p.gconv = (const float*)d_in[6]; p.Alog = (const float*)d_in[7];
    p.dtb = (const float*)d_in[8]; p.gnw = (const float*)d_in[9]; p.mconv = (const float*)d_in[10]; p.mbi = (const float*)d_in[11];
    p.mbf = (const float*)d_in[12]; p.mnw = (const float*)d_in[13]; p.wpa = (const float*)d_in[14]; p.wpb = (const float*)d_in[15];
    p.wout = (const float*)d_in[16]; p.npost = (const float*)d_in[17];
    p.out = (float*)d_out; p.ws = (unsigned char*)d_ws;
    if (ws_size < WS_NEED) { fprintf(stderr, "workspace too small: %zu < %zu\n", ws_size, (size_t)WS_NEED); return; }
#if MK_MULTI
    launch_one<0>(p, stream); launch_one<1>(p, stream); launch_one<2>(p, stream); launch_one<3>(p, stream); launch_one<4>(p, stream);
    launch_one<5>(p, stream); launch_one<6>(p, stream); launch_one<7>(p, stream); launch_one<8>(p, stream);
#else
    static int grid_blocks = 0;
    if (!grid_blocks) {
        int dev = 0, cus = 0, per_cu = 0;
        hipGetDevice(&dev);
        hipDeviceGetAttribute(&cus, hipDeviceAttributeMultiprocessorCount, dev);
        hipFuncSetAttribute((const void*)mk_kernel<-1>, hipFuncAttributeMaxDynamicSharedMemorySize, LDS_BYTES);
        hipOccupancyMaxActiveBlocksPerMultiprocessor(&per_cu, mk_kernel<-1>, 512, LDS_BYTES);
        grid_blocks = cus * per_cu;
        if (grid_blocks > 256) grid_blocks = 256;
    }
    void* args[] = {&p};
    hipError_t e = hipLaunchCooperativeKernel((void*)mk_kernel<-1>, dim3(grid_blocks), dim3(512), args, LDS_BYTES, stream);
    if (e != hipSuccess) fprintf(stderr, "cooperative launch failed: %s (grid %d)\n", hipGetErrorString(e), grid_blocks);
#endif
}
```
